# Optimizing an MI355X kernel written in HIP

```python
import jax, jax.numpy as jnp
from jax import lax
import numpy as np

D_MODEL = 1024
BATCH = 8
SEQ = 2048
DEPTH = 1

HEAD_DIM = 64
SCALE = HEAD_DIM ** -0.5
EPS = 1e-6
NEG = -1e30
DIL_PAIRS = ((128, 1), (512, 4), (2048, 16))
N_DIL_GROUPS = len(DIL_PAIRS)
HEADS_A = 8
WIDTH_A = N_DIL_GROUPS * HEADS_A * HEAD_DIM
OUT_A = HEADS_A * HEAD_DIM
ROT_DIM_A = HEAD_DIM // 4
THETA_PARTIAL = 500000.0
HEADS_B_Q = 8
HEADS_B_KV = 2
WIDTH_B_Q = HEADS_B_Q * HEAD_DIM
WIDTH_B_KV = HEADS_B_KV * HEAD_DIM
OUT_B = WIDTH_B_Q
Q_BLOCK = 128
GRID_W = 64
THETA_AXIAL = 10000.0
N_BRANCHES = 2
IN_COLS = 3 * WIDTH_A + WIDTH_B_Q + 2 * WIDTH_B_KV + N_BRANCHES * D_MODEL
N_EXPERTS = 32
TOP_K = 4
D_FF = 1024
SWIGLU_LIMIT = 7.0
SWIGLU_ALPHA = 1.702
EXPERT_BLOCK = 128

kernel_name = "hybrid_dilated_axial_gqa_moe_block"


def rmsnorm(x, g):
    xf = x.astype(jnp.float32)
    y = xf * lax.rsqrt(jnp.mean(xf * xf, axis=-1, keepdims=True) + EPS)
    return (y * g).astype(x.dtype)


def rope(x, pos, theta):
    half = x.shape[-1] // 2
    inv = theta ** (-(jnp.arange(half, dtype=jnp.float32) / half))
    ang = pos.astype(jnp.float32)[:, None] * inv[None, :]
    cos, sin = jnp.cos(ang)[:, None, :], jnp.sin(ang)[:, None, :]
    xf = x.astype(jnp.float32)
    x1, x2 = xf[..., :half], xf[..., half:]
    return jnp.concatenate([x1 * cos - x2 * sin, x2 * cos + x1 * sin], axis=-1).astype(x.dtype)


def partial_rope(x, pos):
    return jnp.concatenate([rope(x[..., :ROT_DIM_A], pos, THETA_PARTIAL), x[..., ROT_DIM_A:]], axis=-1)


def axial_rope(x, row, col):
    h = x.shape[-1] // 2
    return jnp.concatenate([rope(x[..., :h], row, THETA_AXIAL), rope(x[..., h:], col, THETA_AXIAL)], axis=-1)


def _pad_axis3(x, lo, hi):
    return jnp.pad(x, ((0, 0), (0, 0), (0, 0), (lo, hi), (0, 0)))


def dilated_window_attention(q, k, v, window, dil):
    b, s, h, e = q.shape
    half = window // (2 * dil)
    L = s // dil
    nb = -(-L // half)
    lp = nb * half
    pad = lp - L

    def to_sub(t):
        return t.reshape(b, L, dil, h, e).transpose(0, 2, 3, 1, 4)

    qs, ks, vs = to_sub(q), to_sub(k), to_sub(v)
    qb = _pad_axis3(qs, 0, pad).reshape(b, dil, h, nb, half, e)

    def windows(t):
        tp = _pad_axis3(t, half, pad + half).reshape(b, dil, h, nb + 2, half, e)
        return jnp.concatenate([tp[:, :, :, :-2], tp[:, :, :, 1:-1], tp[:, :, :, 2:]], axis=4)

    kw, vw = windows(ks), windows(vs)
    sc = jnp.einsum('bdhnqe,bdhnke->bdhnqk', qb, kw).astype(jnp.float32) * SCALE
    blk = jnp.arange(nb)[:, None, None]
    qi = blk * half + jnp.arange(half)[None, :, None]
    ki = (blk - 1) * half + jnp.arange(3 * half)[None, None, :]
    valid = (jnp.abs(ki - qi) <= half) & (ki >= 0) & (ki < L)
    sc = jnp.where(valid, sc, NEG)
    lse = jax.nn.logsumexp(sc, axis=-1)
    p = jnp.exp(sc - lse[..., None])
    o = jnp.einsum('bdhnqk,bdhnke->bdhnqe', p.astype(v.dtype), vw)
    o = o.reshape(b, dil, h, lp, e)[:, :, :, :L].transpose(0, 3, 1, 2, 4).reshape(b, s, h, e)
    lse = lse.reshape(b, dil, h, lp)[..., :L].transpose(0, 3, 1, 2).reshape(b, s, h)
    return o, lse


def gqa_blocked_attention(q, k, v):
    b, s, hq, e = q.shape
    hkv = k.shape[2]
    g = hq // hkv
    nq = s // Q_BLOCK
    qb = q.reshape(b, nq, Q_BLOCK, hkv, g, e).transpose(1, 0, 3, 4, 2, 5)
    kt = k.transpose(0, 2, 1, 3)
    vt = v.transpose(0, 2, 1, 3)

    def one_block(qblk):
        sc = jnp.einsum('bkgqe,bkse->bkgqs', qblk, kt).astype(jnp.float32) * SCALE
        p = jax.nn.softmax(sc, axis=-1)
        return jnp.einsum('bkgqs,bkse->bkgqe', p.astype(vt.dtype), vt)

    ob = lax.map(one_block, qb)
    return ob.transpose(1, 0, 4, 2, 3, 5).reshape(b, s, hq * e)


def moe_ffn(h, w_router, b_router, w_gate_up, b_gate_up, w_down, b_down):
    t, d = h.shape
    logits = (h @ w_router).astype(jnp.float32) + b_router
    topv, idx = lax.top_k(logits, TOP_K)
    gates = jax.nn.softmax(topv, axis=-1)
    a = t * TOP_K
    flat_e = idx.reshape(a)
    flat_w = gates.reshape(a)
    flat_tok = jnp.arange(a) // TOP_K
    order = jnp.argsort(flat_e)
    e_s, tok_s, w_s = flat_e[order], flat_tok[order], flat_w[order]
    counts = jnp.bincount(flat_e, length=N_EXPERTS)
    starts = jnp.cumsum(counts) - counts
    padded = ((counts + EXPERT_BLOCK - 1) // EXPERT_BLOCK) * EXPERT_BLOCK
    pends = jnp.cumsum(padded)
    pstarts = pends - padded
    dest = pstarts[e_s] + (jnp.arange(a) - starts[e_s])
    p_rows = a + N_EXPERTS * EXPERT_BLOCK
    n_blk = p_rows // EXPERT_BLOCK
    block_e = jnp.clip(jnp.searchsorted(pends, jnp.arange(n_blk) * EXPERT_BLOCK, side='right'), 0, N_EXPERTS - 1)
    xbuf = jnp.zeros((p_rows, d), h.dtype).at[dest].set(h[tok_s])
    wbuf = jnp.zeros((p_rows,), jnp.float32).at[dest].set(w_s)
    tbuf = jnp.zeros((p_rows,), jnp.int32).at[dest].set(tok_s.astype(jnp.int32))

    def expert_block(args):
        xblk, e = args
        gu = xblk @ w_gate_up[e] + b_gate_up[e]
        gate = jnp.minimum(gu[:, :D_FF], SWIGLU_LIMIT)
        up = jnp.clip(gu[:, D_FF:], -SWIGLU_LIMIT, SWIGLU_LIMIT)
        act = (up + 1.0) * (gate * jax.nn.sigmoid(SWIGLU_ALPHA * gate))
        return act @ w_down[e] + b_down[e]

    ybuf = lax.map(expert_block, (xbuf.reshape(n_blk, EXPERT_BLOCK, d), block_e)).reshape(p_rows, d)
    out = jnp.zeros((t, d), jnp.float32).at[tbuf].add(ybuf.astype(jnp.float32) * wbuf[:, None])
    return out


def setup_inputs(seed: int = 0) -> dict:
    key = jax.random.key(seed)
    ks = jax.random.split(key, 18)
    f32 = jnp.float32
    nrm = lambda k, shp: jax.random.normal(k, shp, f32)
    return {
        "x": nrm(ks[0], (BATCH, SEQ, D_MODEL)),
        "norm_mix_g": 1.0 + 0.02 * nrm(ks[1], (D_MODEL,)),
        "w_in": nrm(ks[2], (D_MODEL, IN_COLS)) * D_MODEL ** -0.5,
        "b_gate": 0.1 * nrm(ks[3], (N_BRANCHES, D_MODEL)),
        "qn_a": 1.0 + 0.02 * nrm(ks[4], (N_DIL_GROUPS, HEAD_DIM)),
        "kn_a": 1.0 + 0.02 * nrm(ks[5], (N_DIL_GROUPS, HEAD_DIM)),
        "qn_b": 1.0 + 0.02 * nrm(ks[6], (HEAD_DIM,)),
        "kn_b": 1.0 + 0.02 * nrm(ks[7], (HEAD_DIM,)),
        "w_proj_a": nrm(ks[8], (OUT_A, D_MODEL)) * OUT_A ** -0.5,
        "w_proj_b": nrm(ks[9], (OUT_B, D_MODEL)) * OUT_B ** -0.5,
        "w_out": nrm(ks[10], (D_MODEL, D_MODEL)) * D_MODEL ** -0.5,
        "norm_ffn_g": 1.0 + 0.02 * nrm(ks[11], (D_MODEL,)),
        "w_router": nrm(ks[12], (D_MODEL, N_EXPERTS)) * D_MODEL ** -0.5,
        "b_router": 0.01 * nrm(ks[13], (N_EXPERTS,)),
        "w_gate_up": nrm(ks[14], (N_EXPERTS, D_MODEL, 2 * D_FF)) * D_MODEL ** -0.5,
        "b_gate_up": 0.02 * nrm(ks[15], (N_EXPERTS, 2 * D_FF)),
        "w_down": nrm(ks[16], (N_EXPERTS, D_FF, D_MODEL)) * D_FF ** -0.5,
        "b_down": 0.02 * nrm(ks[17], (N_EXPERTS, D_MODEL)),
    }


def reference(x, norm_mix_g, w_in, b_gate, qn_a, kn_a, qn_b, kn_b, w_proj_a, w_proj_b, w_out,
              norm_ffn_g, w_router, b_router, w_gate_up, b_gate_up, w_down, b_down):
    b, s, d = x.shape
    pos = jnp.arange(s)
    rows = s // GRID_W
    row = jnp.repeat(jnp.arange(rows), GRID_W)
    col = jnp.tile(jnp.arange(GRID_W), rows)
    split_at = list(np.cumsum([3 * WIDTH_A, WIDTH_B_Q, WIDTH_B_KV, WIDTH_B_KV]))

    for _layer in range(DEPTH):
        h = rmsnorm(x, norm_mix_g)
        proj = h @ w_in
        qkv_a, q_b, k_b, v_b, gate_logits = jnp.split(proj, split_at, axis=-1)

        qkv_a = qkv_a.reshape(b, s, 3, N_DIL_GROUPS, HEADS_A, HEAD_DIM)
        outs, lses = [], []
        for gi, (window, dil) in enumerate(DIL_PAIRS):
            qg = partial_rope(rmsnorm(qkv_a[:, :, 0, gi], qn_a[gi]), pos)
            kg = partial_rope(rmsnorm(qkv_a[:, :, 1, gi], kn_a[gi]), pos)
            og, lg = dilated_window_attention(qg, kg, qkv_a[:, :, 2, gi], window, dil)
            outs.append(og)
            lses.append(lg)
        wts = jax.nn.softmax(jnp.stack(lses, axis=0), axis=0)
        o_a = jnp.sum(wts[..., None] * jnp.stack(outs, axis=0).astype(jnp.float32), axis=0)
        o_a = o_a.astype(x.dtype).reshape(b, s, OUT_A)

        qb = axial_rope(rmsnorm(q_b.reshape(b, s, HEADS_B_Q, HEAD_DIM), qn_b), row, col)
        kb = axial_rope(rmsnorm(k_b.reshape(b, s, HEADS_B_KV, HEAD_DIM), kn_b), row, col)
        vb = v_b.reshape(b, s, HEADS_B_KV, HEAD_DIM)
        o_b = gqa_blocked_attention(qb, kb, vb)

        gates = jax.nn.sigmoid(gate_logits.reshape(b, s, N_BRANCHES, d) + b_gate)
        merged = gates[:, :, 0] * (o_a @ w_proj_a) + gates[:, :, 1] * (o_b @ w_proj_b)
        x = x + (merged @ w_out).astype(x.dtype)

        h2 = rmsnorm(x, norm_ffn_g).reshape(b * s, d)
        ff = moe_ffn(h2, w_router, b_router, w_gate_up, b_gate_up, w_down, b_down)
        x = x + ff.reshape(b, s, d).astype(x.dtype)
    return x
```

```cpp
#include <hip/hip_runtime.h>
#include <cstdio>
#include <cstdint>
#include <cstring>
namespace pg8 {
#define PG8_LAS __attribute__((address_space(3)))
typedef unsigned short bf16_t;
typedef short bf16x8 __attribute__((ext_vector_type(8)));
typedef float f32x4 __attribute__((ext_vector_type(4)));
typedef unsigned u32x4 __attribute__((ext_vector_type(4)));
constexpr int BM = 256, BK = 64, HALF = 128, HTB = HALF * BK * 2  , STAGE_BYTES = 8 * HTB, NXCD = 8, WGM = 8;

__host__ __device__ __forceinline__ int lds_byte(int r, int c) { const int st = (r >> 4) * 2 + (c >> 5), rr = r & 15, cc = c & 31, ob = rr * 64 + cc * 2; return st * 1024 + (ob ^ (((ob >> 9) & 1) << 5)); }
__host__ __device__ __forceinline__ void stage_rc(int b, int& R, int& C) { const int st = b / 1024, sb = b % 1024, swz = sb ^ (((sb >> 9) & 1) << 5); R = (st >> 1) * 16 + swz / 64; C = (st & 1) * 32 + (swz % 64) / 2; }
__host__ __device__ __forceinline__ int perm32(int rho) { const int n = rho >> 4, i = rho & 15; return 8 * (i >> 2) + 4 * n + (i & 3); }

struct Unit { int pm, pn; };
struct Gemm { const bf16_t* A; const bf16_t* Bt; int M, N, K, pad; };

struct StaticOrder {
    int nM, nN, nwg, G, c;
    __host__ __device__ void init(int M, int N, int G_, int c_) { nM = M / BM; nN = N / BM; nwg = nM * nN; G = G_; c = c_; }
    __host__ __device__ bool next(int i, Unit& u) const {
        const long L = (long)i * G + c; if (L >= nwg) return false;
        int wgid = (int)L; { const int q = nwg / NXCD, r = nwg % NXCD, xcd = wgid % NXCD, off = wgid / NXCD; wgid = (xcd < r ? xcd * (q + 1) : r * (q + 1) + (xcd - r) * q) + off; }
        const int nig = WGM * nN, gid = wgid / nig, fm = gid * WGM, gsz = (nM - fm) < WGM ? (nM - fm) : WGM;
        u.pm = fm + ((wgid % nig) % gsz); u.pn = (wgid % nig) / gsz; return true;
    }
    __device__ __forceinline__ void a_ready(const Unit&) const {}
    __device__ __forceinline__ void done(const Unit&) const {}
};

__device__ __forceinline__ unsigned cvt_pk_bf16(float lo, float hi) { unsigned r; asm volatile("v_cvt_pk_bf16_f32 %0, %1, %2" : "=v"(r) : "v"(lo), "v"(hi)); return r; }
typedef float f32x2 __attribute__((ext_vector_type(2)));
__device__ __forceinline__ void unpack8(const u32x4 w, float (&f)[8]) {
    f[0] = __uint_as_float(w.x << 16); f[1] = __uint_as_float(w.x & 0xffff0000u); f[2] = __uint_as_float(w.y << 16); f[3] = __uint_as_float(w.y & 0xffff0000u);
    f[4] = __uint_as_float(w.z << 16); f[5] = __uint_as_float(w.z & 0xffff0000u); f[6] = __uint_as_float(w.w << 16); f[7] = __uint_as_float(w.w & 0xffff0000u);
}
__device__ __forceinline__ u32x4 pack8(const float (&f)[8]) { u32x4 w; w.x = cvt_pk_bf16(f[0], f[1]); w.y = cvt_pk_bf16(f[2], f[3]); w.z = cvt_pk_bf16(f[4], f[5]); w.w = cvt_pk_bf16(f[6], f[7]); return w; }

struct EpiStore {
    static constexpr bool PERM = true, AFTER_DRAIN = false;
    bf16_t* O; int ldc, pad;
    __device__ __forceinline__ void operator()(const f32x4 (&acc)[2][2][4][2], const Unit& u, int wr, int wc, int fr, int fq) const {
        const int row0 = u.pm * BM + wr * 64 + fr, col0 = u.pn * BM + wc * 32 + 8 * fq;
#pragma unroll
        for (int ai = 0; ai < 2; ++ai)
#pragma unroll
            for (int m = 0; m < 4; ++m) { bf16_t* rowp = O + (size_t)(row0 + ai * HALF + m * 16) * ldc + col0;
#pragma unroll
                for (int bj = 0; bj < 2; ++bj) { const f32x4 v0 = acc[ai][bj][m][0], v1 = acc[ai][bj][m][1];
                    u32x4 w; w.x = cvt_pk_bf16(v0[0], v0[1]); w.y = cvt_pk_bf16(v0[2], v0[3]); w.z = cvt_pk_bf16(v1[0], v1[1]); w.w = cvt_pk_bf16(v1[2], v1[3]);
                    *(u32x4*)(rowp + bj * HALF) = w; } }
    }
};
template <int MODE> struct EpiGate {
    static constexpr bool PERM = true, AFTER_DRAIN = false;
    const bf16_t* G; bf16_t* TMP; bf16_t* OUT;
    __device__ __forceinline__ void operator()(const f32x4 (&acc)[2][2][4][2], const Unit& u, int wr, int wc, int fr, int fq) const {
        const int row0 = u.pm * BM + wr * 64 + fr, col0 = u.pn * BM + wc * 32 + 8 * fq;
#pragma unroll
        for (int ai = 0; ai < 2; ++ai)
#pragma unroll
            for (int m = 0; m < 4; ++m) { const size_t row = (size_t)(row0 + ai * HALF + m * 16);
#pragma unroll
                for (int bj = 0; bj < 2; ++bj) { const int col = col0 + bj * HALF; const f32x4 v0 = acc[ai][bj][m][0], v1 = acc[ai][bj][m][1];
                    float g[8], o[8]; unpack8(*(const u32x4*)(G + row * 2048 + MODE * 1024 + col), g);
                    const float v[8] = {v0[0], v0[1], v0[2], v0[3], v1[0], v1[1], v1[2], v1[3]};
                    if (MODE == 0) {
#pragma unroll
                        for (int i = 0; i < 8; ++i) o[i] = g[i] * v[i];
                        *(u32x4*)(TMP + row * 1024 + col) = pack8(o);
                    } else { float t[8]; unpack8(*(const u32x4*)(TMP + row * 1024 + col), t);
#pragma unroll
                        for (int i = 0; i < 8; ++i) o[i] = t[i] + g[i] * v[i];
                        *(u32x4*)(OUT + row * 1024 + col) = pack8(o); } } }
    }
};
struct EpiRes {
    static constexpr bool PERM = false, AFTER_DRAIN = false;
    const float* base; float* out; int ldc, pad;
    __device__ __forceinline__ void operator()(const f32x4 (&acc)[2][2][4][2], const Unit& u, int wr, int wc, int fr, int fq) const {
        const int row0 = u.pm * BM + wr * 64 + fr, col0 = u.pn * BM + wc * 32 + 4 * fq;
#pragma unroll
        for (int ai = 0; ai < 2; ++ai)
#pragma unroll
            for (int m = 0; m < 4; ++m) { const size_t off = (size_t)(row0 + ai * HALF + m * 16) * ldc + col0;
#pragma unroll
                for (int bj = 0; bj < 2; ++bj)
#pragma unroll
                    for (int n = 0; n < 2; ++n) { const f32x4 b = *(const f32x4*)(base + off + bj * HALF + n * 16); *(f32x4*)(out + off + bj * HALF + n * 16) = b + acc[ai][bj][m][n]; } }
    }
};
struct EpiSwiglu {
    static constexpr bool PERM = true, AFTER_DRAIN = false;
    const float* bgu; bf16_t* ACT;
    __device__ __forceinline__ void operator()(const f32x4 (&acc)[2][2][4][2], const Unit& u, int wr, int wc, int fr, int fq) const {
        const int e = u.pn >> 3, pnl = u.pn & 7, colh = pnl * 128 + wc * 32 + 8 * fq, row0 = u.pm * BM + wr * 64 + fr;
        const float* bg = bgu + (size_t)e * 2048 + colh; const float* bu = bg + 1024;
        const f32x4 bg0 = *(const f32x4*)bg, bg1 = *(const f32x4*)(bg + 4), bu0 = *(const f32x4*)bu, bu1 = *(const f32x4*)(bu + 4);
#pragma unroll
        for (int ai = 0; ai < 2; ++ai)
#pragma unroll
            for (int m = 0; m < 4; ++m) { const size_t row = (size_t)(row0 + ai * HALF + m * 16);
                const f32x4 g0 = acc[ai][0][m][0] + bg0, g1 = acc[ai][0][m][1] + bg1, u0 = acc[ai][1][m][0] + bu0, u1 = acc[ai][1][m][1] + bu1;
                const float gv[8] = {g0[0], g0[1], g0[2], g0[3], g1[0], g1[1], g1[2], g1[3]}, uv[8] = {u0[0], u0[1], u0[2], u0[3], u1[0], u1[1], u1[2], u1[3]};
                float o[8];
#pragma unroll
                for (int i = 0; i < 8; ++i) { const float gate = fminf(gv[i], 7.0f), up = fminf(fmaxf(uv[i], -7.0f), 7.0f);
                    const float sg = __builtin_amdgcn_rcpf(1.0f + __builtin_amdgcn_exp2f(gate * (-1.702f * 1.4426950408889634f)));
                    o[i] = (up + 1.0f) * (gate * sg); }
                *(u32x4*)(ACT + row * 1024 + colh) = pack8(o); }
    }
};
struct EpiDown {
    static constexpr bool PERM = true, AFTER_DRAIN = false;
    const float* bd; const float* rowgate; bf16_t* Y;
    __device__ __forceinline__ void operator()(const f32x4 (&acc)[2][2][4][2], const Unit& u, int wr, int wc, int fr, int fq) const {
        const int e = u.pn >> 2, pnl = u.pn & 3, col0 = pnl * 256 + wc * 32 + 8 * fq, row0 = u.pm * BM + wr * 64 + fr;
        f32x4 b[2][2];
#pragma unroll
        for (int bj = 0; bj < 2; ++bj)
#pragma unroll
            for (int n = 0; n < 2; ++n) b[bj][n] = *(const f32x4*)(bd + (size_t)e * 1024 + col0 + bj * HALF + 4 * n);
#pragma unroll
        for (int ai = 0; ai < 2; ++ai)
#pragma unroll
            for (int m = 0; m < 4; ++m) { const size_t row = (size_t)(row0 + ai * HALF + m * 16); const float rg = rowgate[row];
#pragma unroll
                for (int bj = 0; bj < 2; ++bj) { const f32x4 v0 = (acc[ai][bj][m][0] + b[bj][0]) * rg, v1 = (acc[ai][bj][m][1] + b[bj][1]) * rg;
                    u32x4 w; w.x = cvt_pk_bf16(v0[0], v0[1]); w.y = cvt_pk_bf16(v0[2], v0[3]); w.z = cvt_pk_bf16(v1[0], v1[1]); w.w = cvt_pk_bf16(v1[2], v1[3]);
                    *(u32x4*)(Y + row * 1024 + col0 + bj * HALF) = w; } }
    }
};
struct MoeOrder {
    const int* tile_e; int ntiles, nN, G, c;
    __device__ __forceinline__ bool next(int i, Unit& u) const {
        const long L = (long)i * G + c; if (L >= (long)ntiles * nN) return false;
        const int t = (int)(L / nN), pnl = (int)(L % nN); u.pm = t; u.pn = tile_e[t] * nN + pnl; return true; }
    __device__ __forceinline__ void a_ready(const Unit&) const {}
    __device__ __forceinline__ void done(const Unit&) const {}
};
template <class Epi, class Sched, bool ALIGN_EPI = false, bool SP2 = false>
__device__ __forceinline__ void gemm_phase(PG8_LAS unsigned char* lds, const Gemm g, const Sched& S, const Epi& E) {
    const int tid = threadIdx.x, wid = __builtin_amdgcn_readfirstlane(tid >> 6), lane = tid & 63, wr = wid >> 2, wc = wid & 3, fr = lane & 15, fq = lane >> 4;
    const int K = g.K, nt = K / BK;
    unsigned voffA[2], voffB[2];
#pragma unroll
    for (int i = 0; i < 2; ++i) { int R, C; stage_rc(tid * 16 + i * 8192, R, C); const int Rb = Epi::PERM ? ((R & ~31) + perm32(R & 31)) : R;
        voffA[i] = (unsigned)(R * K + C) * 2u; voffB[i] = (unsigned)(Rb * K + C) * 2u; }
    const size_t kstep = (size_t)(BK * 2);
    const size_t hstep = (size_t)HALF * K * 2;
    const size_t tstep = 2 * hstep;
    const unsigned ldsw = (unsigned)wid * 1024u;
    const int aoff = lds_byte(wr * 64 + fr, fq * 8), boff = lds_byte(wc * 32 + fr, fq * 8);
#define PG8_SA(b, h) (((b) * 2 + (h)) * HTB)
#define PG8_SB(b, h) ((4 + (b) * 2 + (h)) * HTB)
#define PG8_STAGE(bufoff, gbase, voff) do { _Pragma("unroll") for (int _i = 0; _i < 2; ++_i) \
        __builtin_amdgcn_global_load_lds((const unsigned*)((const char*)(gbase) + (voff)[_i]), (PG8_LAS unsigned*)(lds + (bufoff) + ldsw + _i * 8192), 16, 0, 0); } while (0)
#define PG8_LDA(dst, b, h) do { _Pragma("unroll") for (int m = 0; m < 4; ++m) _Pragma("unroll") for (int k = 0; k < 2; ++k) dst[m][k] = *(const PG8_LAS bf16x8*)(lds + PG8_SA(b, h) + aoff + m * 2048 + k * 1024); } while (0)
#define PG8_LDB(dst, b, h) do { _Pragma("unroll") for (int n = 0; n < 2; ++n) _Pragma("unroll") for (int k = 0; k < 2; ++k) dst[n][k] = *(const PG8_LAS bf16x8*)(lds + PG8_SB(b, h) + boff + n * 2048 + k * 1024); } while (0)
#define PG8_MMA(ai, bj, At, Bt) do { __builtin_amdgcn_s_setprio(1); _Pragma("unroll") for (int m = 0; m < 4; ++m) _Pragma("unroll") for (int n = 0; n < 2; ++n) _Pragma("unroll") for (int k = 0; k < 2; ++k) \
        acc[ai][bj][m][n] = __builtin_amdgcn_mfma_f32_16x16x32_bf16(Bt[n][k], At[m][k], acc[ai][bj][m][n], 0, 0, 0); __builtin_amdgcn_s_setprio(0); } while (0)
#define PG8_WAIT_V(n) asm volatile("s_waitcnt vmcnt(" #n ")" ::: "memory")
#define PG8_WAIT_L(n) asm volatile("s_waitcnt lgkmcnt(" #n ")" ::: "memory")
#define PG8_BAR __builtin_amdgcn_s_barrier()
#define PG8_SCHED __builtin_amdgcn_sched_barrier(0)
    Unit cur, nxt; int ui = 0;
    if (!S.next(0, cur)) return;
    f32x4 acc[2][2][4][2];
#pragma unroll
    for (int a = 0; a < 2; ++a)
#pragma unroll
        for (int b = 0; b < 2; ++b)
#pragma unroll
            for (int m = 0; m < 4; ++m)
#pragma unroll
                for (int n = 0; n < 2; ++n) acc[a][b][m][n] = (f32x4){0.f, 0.f, 0.f, 0.f};
    bf16x8 At[4][2], B0[2][2], B1[2][2];
    const char* cA = (const char*)g.A + (size_t)cur.pm * tstep; const char* cB = (const char*)g.Bt + (size_t)cur.pn * tstep;
    S.a_ready(cur);
    if constexpr (SP2) {
        PG8_STAGE(PG8_SB(0, 0), cB, voffB); PG8_STAGE(PG8_SB(0, 1), cB + hstep, voffB); PG8_STAGE(PG8_SA(0, 0), cA, voffA); PG8_STAGE(PG8_SA(0, 1), cA + hstep, voffA);
        if (wr == 1) PG8_BAR;
        PG8_WAIT_V(2); PG8_BAR;
        PG8_STAGE(PG8_SB(1, 0), cB + kstep, voffB); PG8_STAGE(PG8_SA(1, 0), cA + kstep, voffA); PG8_STAGE(PG8_SB(1, 1), cB + hstep + kstep, voffB);
        PG8_WAIT_V(6); PG8_BAR;
    } else {
        PG8_STAGE(PG8_SB(0, 0), cB, voffB); PG8_STAGE(PG8_SA(0, 0), cA, voffA); PG8_STAGE(PG8_SB(0, 1), cB + hstep, voffB); PG8_STAGE(PG8_SA(0, 1), cA + hstep, voffA);
        if (wr == 1) PG8_BAR;
        PG8_WAIT_V(4); PG8_BAR;
        PG8_STAGE(PG8_SB(1, 0), cB + kstep, voffB); PG8_STAGE(PG8_SA(1, 0), cA + kstep, voffA); PG8_STAGE(PG8_SB(1, 1), cB + hstep + kstep, voffB);
        PG8_WAIT_V(6); PG8_BAR;
    }
    for (;;) {
        const bool has_next = S.next(ui + 1, nxt);
        const char* nA = has_next ? (const char*)g.A + (size_t)nxt.pm * tstep : cA; const char* nB = has_next ? (const char*)g.Bt + (size_t)nxt.pn * tstep : cB;
        for (int t = 0; t < nt; t += 2) {
            const bool last = (t == nt - 2);
            const char* a1 = cA + (size_t)(t + 1) * kstep;
            const char* a2 = last ? nA : cA + (size_t)(t + 2) * kstep; const char* b2 = last ? nB : cB + (size_t)(t + 2) * kstep;
            const char* a3 = a2 + kstep; const char* b3 = b2 + kstep;
            if (last && has_next) S.a_ready(nxt);
            if constexpr (SP2) {
            PG8_LDB(B0, 0, 0); PG8_LDB(B1, 0, 1); PG8_SCHED; PG8_LDA(At, 0, 0); PG8_STAGE(PG8_SA(1, 1), a1 + hstep, voffA);
            PG8_WAIT_V(8); PG8_WAIT_L(0); PG8_BAR; PG8_MMA(0, 0, At, B0); PG8_MMA(0, 1, At, B1); PG8_BAR; PG8_SCHED;
            PG8_LDA(At, 0, 1); PG8_STAGE(PG8_SB(0, 0), b2, voffB); PG8_STAGE(PG8_SB(0, 1), b2 + hstep, voffB); PG8_STAGE(PG8_SA(0, 0), a2, voffA);
            PG8_WAIT_V(8); PG8_WAIT_L(0); PG8_BAR; PG8_MMA(1, 0, At, B0); PG8_MMA(1, 1, At, B1); PG8_BAR; PG8_SCHED;
            PG8_LDB(B0, 1, 0); PG8_LDB(B1, 1, 1); PG8_SCHED; PG8_LDA(At, 1, 0); PG8_STAGE(PG8_SA(0, 1), a2 + hstep, voffA);
            PG8_WAIT_V(8); PG8_WAIT_L(0); PG8_BAR; PG8_MMA(0, 0, At, B0); PG8_MMA(0, 1, At, B1); PG8_BAR; PG8_SCHED;
            PG8_LDA(At, 1, 1); PG8_STAGE(PG8_SB(1, 0), b3, voffB); PG8_STAGE(PG8_SB(1, 1), b3 + hstep, voffB); PG8_STAGE(PG8_SA(1, 0), a3, voffA);
            PG8_WAIT_V(8); PG8_WAIT_L(0); PG8_BAR; PG8_MMA(1, 0, At, B0); PG8_MMA(1, 1, At, B1); PG8_BAR; PG8_SCHED;
            } else {
            PG8_LDB(B0, 0, 0); PG8_SCHED; PG8_LDA(At, 0, 0); PG8_STAGE(PG8_SA(1, 1), a1 + hstep, voffA);
            PG8_WAIT_L(8); PG8_BAR; PG8_WAIT_L(0); PG8_MMA(0, 0, At, B0); PG8_BAR; PG8_SCHED;
            PG8_LDB(B1, 0, 1); PG8_STAGE(PG8_SB(0, 0), b2, voffB);
            PG8_BAR; PG8_WAIT_L(0); PG8_MMA(0, 1, At, B1); PG8_BAR;
            PG8_LDA(At, 0, 1); PG8_STAGE(PG8_SA(0, 0), a2, voffA);
            PG8_BAR; PG8_WAIT_L(0); PG8_MMA(1, 0, At, B0); PG8_BAR; PG8_SCHED;
            PG8_STAGE(PG8_SB(0, 1), b2 + hstep, voffB);
            PG8_WAIT_V(6); PG8_BAR; PG8_MMA(1, 1, At, B1); PG8_BAR;
            PG8_LDB(B0, 1, 0); PG8_SCHED; PG8_LDA(At, 1, 0); PG8_STAGE(PG8_SA(0, 1), a2 + hstep, voffA);
            PG8_WAIT_L(8); PG8_BAR; PG8_WAIT_L(0); PG8_MMA(0, 0, At, B0); PG8_BAR; PG8_SCHED;
            PG8_LDB(B1, 1, 1); PG8_STAGE(PG8_SB(1, 0), b3, voffB);
            PG8_BAR; PG8_WAIT_L(0); PG8_MMA(0, 1, At, B1); PG8_BAR;
            PG8_LDA(At, 1, 1); PG8_STAGE(PG8_SA(1, 0), a3, voffA);
            PG8_BAR; PG8_WAIT_L(0); PG8_MMA(1, 0, At, B0); PG8_BAR; PG8_SCHED;
            PG8_STAGE(PG8_SB(1, 1), b3 + hstep, voffB);
            PG8_WAIT_V(6); PG8_BAR; PG8_MMA(1, 1, At, B1); PG8_BAR;
            }
        }
        if constexpr (ALIGN_EPI) { if (wr == 0) PG8_BAR; }
        if constexpr (!Epi::AFTER_DRAIN) { E(acc, cur, wr, wc, fr, fq); S.done(cur); }
        if (!has_next) break;
#pragma unroll
        for (int a = 0; a < 2; ++a)
#pragma unroll
            for (int b = 0; b < 2; ++b)
#pragma unroll
                for (int m = 0; m < 4; ++m)
#pragma unroll
                    for (int n = 0; n < 2; ++n) acc[a][b][m][n] = (f32x4){0.f, 0.f, 0.f, 0.f};
        cur = nxt; cA = nA; cB = nB; ++ui;
        if constexpr (ALIGN_EPI) { if (wr == 1) PG8_BAR; }
    }
    PG8_WAIT_V(0);
    if constexpr (!ALIGN_EPI) { if (wr == 0) PG8_BAR; }
    PG8_BAR;
    if constexpr (Epi::AFTER_DRAIN) { E.fused(acc, cur, wr, wc, fr, fq, lds, wid, lane); S.done(cur); }
#undef PG8_SA
#undef PG8_SB
#undef PG8_STAGE
#undef PG8_LDA
#undef PG8_LDB
#undef PG8_MMA
#undef PG8_WAIT_V
#undef PG8_WAIT_L
#undef PG8_BAR
#undef PG8_SCHED
}
}
constexpr int BATCH = 8, SEQ = 2048, DM = 1024, TOK = BATCH * SEQ;
constexpr int NIN = 7424;
constexpr int NEXP = 32, DFF = 1024, TOPK = 4;
constexpr int MAXTILES = TOK * TOPK / 256 + NEXP;
constexpr int LISTCAP = TOK;
constexpr float EPS = 1e-6f;
constexpr float C2 = 0.125f * 1.4426950408889634f;

typedef unsigned short bf16;
typedef float f32x4 __attribute__((ext_vector_type(4)));
typedef unsigned u32x4 __attribute__((ext_vector_type(4)));
typedef unsigned u32x2 __attribute__((ext_vector_type(2)));
typedef float f32x2v __attribute__((ext_vector_type(2)));
#define LAS __attribute__((address_space(3)))

__device__ __forceinline__ unsigned f2bf(float f) { unsigned u = __builtin_bit_cast(unsigned, f); return (u + 0x7fffu + ((u >> 16) & 1u)) >> 16; }
__device__ __forceinline__ unsigned pk2(float lo, float hi) { return f2bf(lo) | (f2bf(hi) << 16); }
__device__ __forceinline__ float bf2f(bf16 h) { return __uint_as_float((unsigned)h << 16); }
__device__ __forceinline__ float wave_sum(float v) {
#pragma unroll
    for (int o = 1; o < 64; o <<= 1) v += __shfl_xor(v, o);
    return v;
}

__host__ __device__ __forceinline__ int physA(int e) { if (e >= 32) return e; const int fq = e >> 3, n = (e >> 2) & 1, j = e & 3; return j < 2 ? 8 * n + 2 * fq + j : 16 + 4 * fq + 2 * n + (j - 2); }
__host__ __device__ __forceinline__ int physB(int e) { const int b = e & 32, fq = (e >> 3) & 3, n = (e >> 2) & 1, j = e & 3; return b + 16 * n + 4 * fq + j; }
__host__ __device__ __forceinline__ int colmap_in(int np) {
    const int pn = np >> 8, p = np & 255, hw = (p >> 5) & 3, e = ((p >> 7) << 5) | (p & 31);
    if (pn < 6)  return (pn >> 1) * 512 + (4 * (pn & 1) + hw) * 64 + physA(e);
    if (pn < 12) return 1536 + ((pn - 6) >> 1) * 512 + (4 * ((pn - 6) & 1) + hw) * 64 + physA(e);
    if (pn < 18) return 3072 + (pn - 12) * 256 + p;
    if (pn < 20) return 4608 + (4 * (pn - 18) + hw) * 64 + physB(e);
    if (pn == 20) return hw < 2 ? 5120 + hw * 64 + physB(e) : 5248 + (hw - 2) * 64 + e;
    return 5376 + (pn - 21) * 256 + p;
}
__host__ __device__ __forceinline__ int colmap_gu(int np) { const int pn = np >> 8, p = np & 255; return p < 128 ? pn * 128 + p : 1024 + pn * 128 + (p - 128); }

constexpr size_t MiB = 1u << 20;
constexpr size_t WS_CTL = 0;
constexpr size_t CTL_ZERO_BYTES = 1 * MiB;
constexpr size_t WS_TAB = 1 * MiB;
constexpr size_t WS_LIST = 2 * MiB;
constexpr size_t WS_PAIR = 6 * MiB;
constexpr size_t WS_ROWG = 7 * MiB;
constexpr size_t WS_WIN = 8 * MiB;
constexpr size_t WS_WPA = 23 * MiB;
constexpr size_t WS_WPB = 24 * MiB;
constexpr size_t WS_WOUT = 25 * MiB;
constexpr size_t WS_WGU = 28 * MiB;
constexpr size_t WS_WD = 156 * MiB;
constexpr size_t WS_XN = 220 * MiB;
constexpr size_t WS_QA = 252 * MiB;
constexpr size_t WS_KA = 300 * MiB;
constexpr size_t WS_VA = 348 * MiB;
constexpr size_t WS_QB = 396 * MiB;
constexpr size_t WS_KB = 412 * MiB;
constexpr size_t WS_VB = 416 * MiB;
constexpr size_t WS_GATES = 420 * MiB;
constexpr size_t WS_OA = 484 * MiB;
constexpr size_t WS_OB = 500 * MiB;
constexpr size_t WS_TMP = 516 * MiB;
constexpr size_t WS_MRG = 548 * MiB;
constexpr size_t WS_H2 = 580 * MiB;
constexpr size_t WS_XBUF = 612 * MiB;
constexpr size_t WS_ACT = 756 * MiB;
constexpr size_t WS_Y = 252 * MiB;
constexpr size_t WS_PROJ = 612 * MiB;
constexpr size_t WS_END = 900 * MiB;
constexpr int CW_CNT = 64;
constexpr size_t TAB_ROPEA = 0;
constexpr size_t TAB_ROW = 128 * 1024;
constexpr size_t TAB_COL = 132 * 1024;
constexpr size_t TAB_SHIFT = 140 * 1024;
constexpr size_t TAB_META = 141 * 1024;

__global__ void k_tables(const float* qn_a, const float* kn_a, const float* qn_b, const float* kn_b, unsigned char* ws) {
    const int i = blockIdx.x * blockDim.x + threadIdx.x;
    f32x2v* ropeA = (f32x2v*)(ws + WS_TAB + TAB_ROPEA); f32x2v* rowt = (f32x2v*)(ws + WS_TAB + TAB_ROW); f32x2v* colt = (f32x2v*)(ws + WS_TAB + TAB_COL);
    if (i < 2048 * 8) { const int pos = i >> 3, f = i & 7; const double inv = pow(500000.0, -(double)f / 8.0), a = (double)pos * inv; ropeA[i] = (f32x2v){(float)cos(a), (float)sin(a)}; }
    if (i < 32 * 16) { const int pos = i >> 4, f = i & 15; const double inv = pow(10000.0, -(double)f / 16.0), a = (double)pos * inv; rowt[i] = (f32x2v){(float)cos(a), (float)sin(a)}; }
    if (i < 64 * 16) { const int pos = i >> 4, f = i & 15; const double inv = pow(10000.0, -(double)f / 16.0), a = (double)pos * inv; colt[i] = (f32x2v){(float)cos(a), (float)sin(a)}; }
    if (i == 0) {
        float ma = 0.f;
        for (int g = 0; g < 3; ++g) { float q = 0.f, k = 0.f; for (int d = 0; d < 64; ++d) { q = fmaxf(q, fabsf(qn_a[g * 64 + d])); k = fmaxf(k, fabsf(kn_a[g * 64 + d])); } ma = fmaxf(ma, q * k); }
        float q = 0.f, k = 0.f; for (int d = 0; d < 64; ++d) { q = fmaxf(q, fabsf(qn_b[d])); k = fmaxf(k, fabsf(kn_b[d])); }
        float* sh = (float*)(ws + WS_TAB + TAB_SHIFT); sh[0] = 64.f * ma * C2 * 1.02f; sh[1] = 64.f * q * k * C2 * 1.02f;
    }
}

template <int MAP> __device__ __forceinline__ void transpose_item(const float* W, int N, int nblk, bf16* WT, int ldk, int row_off, LAS float* scr, int item, int lane) {
    const int kb = item / nblk, nb = item % nblk, k0 = 64 * kb, n0 = 32 * nb;
    const int np = n0 + (lane & 31); const int cm = MAP == 1 ? colmap_in(np) : (MAP == 2 ? colmap_gu(np) : np);
#pragma unroll 8
    for (int i = 0; i < 32; ++i) { const int kk = 2 * i + (lane >> 5); scr[kk * 33 + (lane & 31)] = W[(size_t)(k0 + kk) * N + cm]; }
    asm volatile("s_waitcnt lgkmcnt(0)" ::: "memory");
    const int c = lane & 7;
#pragma unroll
    for (int j = 0; j < 4; ++j) { const int n = (lane >> 3) + 8 * j; const LAS float* s = scr + (8 * c) * 33 + n;
        u32x4 o; o.x = pk2(s[0 * 33], s[1 * 33]); o.y = pk2(s[2 * 33], s[3 * 33]); o.z = pk2(s[4 * 33], s[5 * 33]); o.w = pk2(s[6 * 33], s[7 * 33]);
        *(u32x4*)(WT + (size_t)(row_off + n0 + n) * ldk + k0 + 8 * c) = o; }
    asm volatile("s_waitcnt lgkmcnt(0)" ::: "memory");
}
struct PrepArgs { const float *x, *g_mix, *w_in, *w_pa, *w_pb, *w_out, *w_gu, *w_d; unsigned char* ws; };
__device__ __forceinline__ void prep_weights(const PrepArgs& a, LAS float* scr, int gw, int NGW, int lane) {
    constexpr int I_IN = 16 * (NIN / 32), I_PA = 8 * 32, I_OUT = 16 * 32, I_GU = 16 * 64, I_D = 16 * 32;
    constexpr int NITEMS = I_IN + 2 * I_PA + I_OUT + NEXP * (I_GU + I_D);
    for (int it = gw; it < NITEMS; it += NGW) {
        int r = it;
        if (r < I_IN) { transpose_item<1>(a.w_in, NIN, NIN / 32, (bf16*)(a.ws + WS_WIN), 1024, 0, scr, r, lane); continue; } r -= I_IN;
        if (r < I_PA) { transpose_item<0>(a.w_pa, 1024, 32, (bf16*)(a.ws + WS_WPA), 512, 0, scr, r, lane); continue; } r -= I_PA;
        if (r < I_PA) { transpose_item<0>(a.w_pb, 1024, 32, (bf16*)(a.ws + WS_WPB), 512, 0, scr, r, lane); continue; } r -= I_PA;
        if (r < I_OUT) { transpose_item<0>(a.w_out, 1024, 32, (bf16*)(a.ws + WS_WOUT), 1024, 0, scr, r, lane); continue; } r -= I_OUT;
        if (r < NEXP * I_GU) { const int e = r / I_GU; transpose_item<2>(a.w_gu + (size_t)e * 1024 * 2048, 2048, 64, (bf16*)(a.ws + WS_WGU), 1024, e * 2048, scr, r % I_GU, lane); continue; } r -= NEXP * I_GU;
        { const int e = r / I_D; transpose_item<0>(a.w_d + (size_t)e * 1024 * 1024, 1024, 32, (bf16*)(a.ws + WS_WD), 1024, e * 1024, scr, r % I_D, lane); }
    }
}
__device__ __forceinline__ void rms_row_to_bf16(const float* xrow, const float* g, bf16* orow, int lane) {
    const f32x4* xr = (const f32x4*)xrow + lane; const f32x4* gr = (const f32x4*)g + lane;
    f32x4 v[4]; float s = 0.f;
#pragma unroll
    for (int j = 0; j < 4; ++j) { v[j] = xr[64 * j]; s += (v[j].x * v[j].x + v[j].y * v[j].y) + (v[j].z * v[j].z + v[j].w * v[j].w); }
    const float rstd = 1.f / sqrtf(wave_sum(s) * (1.f / 1024.f) + EPS);
    unsigned long long* o8 = (unsigned long long*)orow + lane;
#pragma unroll
    for (int j = 0; j < 4; ++j) { const f32x4 gg = gr[64 * j]; o8[64 * j] = (unsigned long long)pk2(v[j].x * rstd * gg.x, v[j].y * rstd * gg.y) | ((unsigned long long)pk2(v[j].z * rstd * gg.z, v[j].w * rstd * gg.w) << 32); }
}
__global__ void __launch_bounds__(256) k_prep(PrepArgs a) {
    __shared__ float scr_all[4 * 64 * 33];
    const int lane = threadIdx.x & 63, wave = threadIdx.x >> 6;
    const int gw = blockIdx.x * 4 + wave, NGW = gridDim.x * 4;
    prep_weights(a, (LAS float*)(scr_all + wave * 64 * 33), gw, NGW, lane);
    for (int m = gw; m < TOK; m += NGW) rms_row_to_bf16(a.x + (size_t)m * DM, a.g_mix, (bf16*)(a.ws + WS_XN) + (size_t)m * DM, lane);
}

struct PostArgs { const float *b_gate, *qn_a, *kn_a, *qn_b, *kn_b; unsigned char* ws; };
__global__ void __launch_bounds__(256) k_post(PostArgs a) {
    const int row = blockIdx.x, lane = threadIdx.x & 63, wave = threadIdx.x >> 6, t = row & (SEQ - 1);
    const bf16* P = (const bf16*)(a.ws + WS_PROJ) + (size_t)row * NIN;
    const f32x2v* ropeA = (const f32x2v*)(a.ws + WS_TAB + TAB_ROPEA); const f32x2v* rowt = (const f32x2v*)(a.ws + WS_TAB + TAB_ROW); const f32x2v* colt = (const f32x2v*)(a.ws + WS_TAB + TAB_COL);
    const int e = lane;
    for (int u = wave; u < 116; u += 4) {
        if (u < 48 || (u >= 72 && u < 82)) {
            const bool isA = u < 48; int pn, hw; const float* gain; bf16* dst; float scale;
            if (u < 24) { const int g = u >> 3, h = u & 7; pn = g * 2 + (h >> 2); hw = h & 3; gain = a.qn_a + g * 64; dst = (bf16*)(a.ws + WS_QA) + (size_t)row * 1536 + g * 512 + h * 64; scale = C2; }
            else if (u < 48) { const int v = u - 24, g = v >> 3, h = v & 7; pn = 6 + g * 2 + (h >> 2); hw = h & 3; gain = a.kn_a + g * 64; dst = (bf16*)(a.ws + WS_KA) + (size_t)row * 1536 + g * 512 + h * 64; scale = 1.f; }
            else if (u < 80) { const int h = u - 72; pn = 18 + (h >> 2); hw = h & 3; gain = a.qn_b; dst = (bf16*)(a.ws + WS_QB) + (size_t)row * 512 + h * 64; scale = C2; }
            else { const int h = u - 80; pn = 20; hw = h; gain = a.kn_b; dst = (bf16*)(a.ws + WS_KB) + (size_t)row * 128 + h * 64; scale = 1.f; }
            const float v = bf2f(P[pn * 256 + 128 * (e >> 5) + 32 * hw + (e & 31)]);
            const int d = isA ? physA(e) : physB(e);
            const float rstd = 1.f / sqrtf(wave_sum(v * v) * (1.f / 64.f) + EPS);
            const float y = v * rstd * gain[d];
            int dp; bool first, rot; f32x2v cs;
            if (isA) { rot = d < 16; first = d < 8; dp = first ? d + 8 : d - 8; cs = ropeA[t * 8 + (d & 7)]; }
            else { const int dd = d & 31; rot = true; first = dd < 16; dp = first ? d + 16 : d - 16; cs = (d < 32) ? rowt[(t >> 6) * 16 + (dd & 15)] : colt[(t & 63) * 16 + (dd & 15)]; }
            int ep = 0;
#pragma unroll 1
            for (int q = 0; q < 64; ++q) { const int dq = isA ? physA(q) : physB(q); if (dq == dp) ep = q; }
            const float yp = __shfl(y, ep);
            float o = y;
            if (rot) o = first ? y * cs.x - yp * cs.y : y * cs.x + yp * cs.y;
            dst[e] = (bf16)f2bf(o * scale);
        } else if (u < 72) {
            const int v = u - 48, g = v >> 3, h = v & 7; const int pn = 12 + g * 2 + (h >> 2);
            ((bf16*)(a.ws + WS_VA))[(size_t)row * 1536 + g * 512 + h * 64 + e] = P[pn * 256 + (h & 3) * 64 + e];
        } else if (u < 84) {
            const int h = u - 82; ((bf16*)(a.ws + WS_VB))[(size_t)row * 128 + h * 64 + e] = P[20 * 256 + 128 * (e >> 5) + 32 * (2 + h) + (e & 31)];
        } else {
            const int c = (u - 84) * 64 + e; const float z = bf2f(P[5376 + c]) + a.b_gate[c];
            ((bf16*)(a.ws + WS_GATES))[(size_t)row * 2048 + c] = (bf16)f2bf(1.f / (1.f + __expf(-z)));
        }
    }
}

__global__ void __launch_bounds__(256) k_attn_a(unsigned char* ws) {
    const int idx = blockIdx.x * 256 + threadIdx.x;
    const int t = idx & (SEQ - 1), h = (idx >> 11) & 7, b = idx >> 14;
    const bf16* QA = (const bf16*)(ws + WS_QA); const bf16* KA = (const bf16*)(ws + WS_KA); const bf16* VA = (const bf16*)(ws + WS_VA);
    const float M0 = ((const float*)(ws + WS_TAB + TAB_SHIFT))[0];
    float o[64]; float l = 0.f;
#pragma unroll
    for (int d = 0; d < 64; ++d) o[d] = 0.f;
    for (int g = 0; g < 3; ++g) {
        const int dil = g == 0 ? 1 : (g == 1 ? 4 : 16);
        float q[64];
        const bf16* qp = QA + (size_t)(b * SEQ + t) * 1536 + g * 512 + h * 64;
#pragma unroll
        for (int d = 0; d < 64; ++d) q[d] = bf2f(qp[d]);
        for (int j = -64; j <= 64; ++j) {
            const int tk = t + j * dil; if (tk < 0 || tk >= SEQ) continue;
            const bf16* kp = KA + (size_t)(b * SEQ + tk) * 1536 + g * 512 + h * 64; const bf16* vp = VA + (size_t)(b * SEQ + tk) * 1536 + g * 512 + h * 64;
            float s = 0.f;
#pragma unroll
            for (int d = 0; d < 64; ++d) s += q[d] * bf2f(kp[d]);
            const float p = exp2f(s - M0); l += p;
#pragma unroll
            for (int d = 0; d < 64; ++d) o[d] += p * bf2f(vp[d]);
        }
    }
    const float rl = 1.f / l; bf16* op = (bf16*)(ws + WS_OA) + (size_t)(b * SEQ + t) * 512 + h * 64;
#pragma unroll
    for (int d = 0; d < 64; ++d) op[d] = (bf16)f2bf(o[d] * rl);
}
__global__ void __launch_bounds__(256) k_attn_b(unsigned char* ws) {
    const int idx = blockIdx.x * 256 + threadIdx.x;
    const int t = idx & (SEQ - 1), h = (idx >> 11) & 7, b = idx >> 14, kvh = h >> 2;
    const bf16* QB = (const bf16*)(ws + WS_QB); const bf16* KB = (const bf16*)(ws + WS_KB); const bf16* VB = (const bf16*)(ws + WS_VB);
    const float M0 = ((const float*)(ws + WS_TAB + TAB_SHIFT))[1];
    float o[64], q[64]; float l = 0.f;
    const bf16* qp = QB + (size_t)(b * SEQ + t) * 512 + h * 64;
#pragma unroll
    for (int d = 0; d < 64; ++d) { o[d] = 0.f; q[d] = bf2f(qp[d]); }
    for (int tk = 0; tk < SEQ; ++tk) {
        const bf16* kp = KB + (size_t)(b * SEQ + tk) * 128 + kvh * 64; const bf16* vp = VB + (size_t)(b * SEQ + tk) * 128 + kvh * 64;
        float s = 0.f;
#pragma unroll
        for (int d = 0; d < 64; ++d) s += q[d] * bf2f(kp[d]);
        const float p = exp2f(s - M0); l += p;
#pragma unroll
        for (int d = 0; d < 64; ++d) o[d] += p * bf2f(vp[d]);
    }
    const float rl = 1.f / l; bf16* op = (bf16*)(ws + WS_OB) + (size_t)(b * SEQ + t) * 512 + h * 64;
#pragma unroll
    for (int d = 0; d < 64; ++d) op[d] = (bf16)f2bf(o[d] * rl);
}

struct RouteArgs { const float* x1; const float *g_ffn, *w_r, *b_r; unsigned char* ws; };
__global__ void __launch_bounds__(256) k_router(RouteArgs a) {
    const int lane = threadIdx.x & 63, wave = threadIdx.x >> 6; const int row = blockIdx.x * 4 + wave;
    const f32x4* xr = (const f32x4*)(a.x1 + (size_t)row * DM) + lane; const f32x4* gr = (const f32x4*)a.g_ffn + lane;
    f32x4 v[4]; float s = 0.f;
#pragma unroll
    for (int j = 0; j < 4; ++j) { v[j] = xr[64 * j]; s += (v[j].x * v[j].x + v[j].y * v[j].y) + (v[j].z * v[j].z + v[j].w * v[j].w); }
    const float rstd = 1.f / sqrtf(wave_sum(s) * (1.f / 1024.f) + EPS);
    unsigned long long* o8 = (unsigned long long*)((bf16*)(a.ws + WS_H2) + (size_t)row * DM) + lane;
    float lg[32];
#pragma unroll
    for (int e = 0; e < 32; ++e) lg[e] = 0.f;
#pragma unroll
    for (int j = 0; j < 4; ++j) { const f32x4 gg = gr[64 * j]; const f32x4 hv = {v[j].x * rstd * gg.x, v[j].y * rstd * gg.y, v[j].z * rstd * gg.z, v[j].w * rstd * gg.w};
        o8[64 * j] = (unsigned long long)pk2(hv.x, hv.y) | ((unsigned long long)pk2(hv.z, hv.w) << 32);
#pragma unroll
        for (int c = 0; c < 4; ++c) { const int k = 256 * j + 4 * lane + c; const f32x4* wr = (const f32x4*)(a.w_r + (size_t)k * 32); const float hk = hv[c];
#pragma unroll
            for (int q = 0; q < 8; ++q) { const f32x4 w = wr[q]; lg[4 * q] += hk * w.x; lg[4 * q + 1] += hk * w.y; lg[4 * q + 2] += hk * w.z; lg[4 * q + 3] += hk * w.w; } } }
#pragma unroll
    for (int e = 0; e < 32; ++e) lg[e] = wave_sum(lg[e]) + a.b_r[e];
    float tv[4]; int ti[4];
#pragma unroll
    for (int k = 0; k < 4; ++k) { float best = -3.0e38f; int bi = 0;
#pragma unroll
        for (int e = 0; e < 32; ++e) { bool taken = false;
#pragma unroll
            for (int kk = 0; kk < 4; ++kk) if (kk < k) taken = taken || (ti[kk] == e);
            if (!taken && lg[e] > best) { best = lg[e]; bi = e; } }
        tv[k] = best; ti[k] = bi; }
    const float e1 = __expf(tv[1] - tv[0]), e2 = __expf(tv[2] - tv[0]), e3 = __expf(tv[3] - tv[0]); const float rs = 1.f / (1.f + e1 + e2 + e3);
    if (lane < 4) {
        const int e = lane == 0 ? ti[0] : lane == 1 ? ti[1] : lane == 2 ? ti[2] : ti[3];
        const float gt = (lane == 0 ? 1.f : lane == 1 ? e1 : lane == 2 ? e2 : e3) * rs;
        unsigned* cnt = (unsigned*)(a.ws + WS_CTL) + CW_CNT;
        const unsigned slot = atomicAdd(cnt + e, 1u);
        int* list = (int*)(a.ws + WS_LIST) + ((size_t)e * LISTCAP + slot) * 2; list[0] = row; list[1] = __float_as_int(gt);
        int* pair = (int*)(a.ws + WS_PAIR) + ((size_t)row * 4 + lane) * 2; pair[0] = e; pair[1] = (int)slot;
    }
}
__global__ void k_route_fin(unsigned char* ws) {
    if (threadIdx.x == 0) {
        const unsigned* cnt = (const unsigned*)(ws + WS_CTL) + CW_CNT; int* meta = (int*)(ws + WS_TAB + TAB_META);
        int base = 0;
        for (int e = 0; e < NEXP; ++e) { const int nt = ((int)cnt[e] + 255) >> 8; meta[1 + e] = base; for (int i = 0; i < nt; ++i) meta[64 + base + i] = e; base += nt; }
        meta[1 + NEXP] = base; meta[0] = base;
    }
}
__global__ void __launch_bounds__(256) k_gather(unsigned char* ws) {
    const int lane = threadIdx.x & 63, wave = threadIdx.x >> 6; const int* meta = (const int*)(ws + WS_TAB + TAB_META); const int nrows = meta[0] * 256;
    const unsigned* cnt = (const unsigned*)(ws + WS_CTL) + CW_CNT;
    for (int row = blockIdx.x * 4 + wave; row < nrows; row += gridDim.x * 4) {
        const int tl = row >> 8, e = meta[64 + tl], slot = row - 256 * meta[1 + e];
        u32x4* dst = (u32x4*)((bf16*)(ws + WS_XBUF) + (size_t)row * DM) + lane;
        if (slot < (int)cnt[e]) { const int* list = (const int*)(ws + WS_LIST) + ((size_t)e * LISTCAP + slot) * 2; const int tok = list[0];
            const u32x4* src = (const u32x4*)((const bf16*)(ws + WS_H2) + (size_t)tok * DM) + lane; dst[0] = src[0]; dst[64] = src[64];
            if (lane == 0) ((float*)(ws + WS_ROWG))[row] = __int_as_float(list[1]);
        } else { dst[0] = (u32x4){0u, 0u, 0u, 0u}; dst[64] = (u32x4){0u, 0u, 0u, 0u}; if (lane == 0) ((float*)(ws + WS_ROWG))[row] = 0.f; }
    }
}
__global__ void __launch_bounds__(256) k_combine(float* out, unsigned char* ws) {
    const int idx = blockIdx.x * 256 + threadIdx.x; const int t = idx >> 7, c8 = (idx & 127) * 8;
    const int* meta = (const int*)(ws + WS_TAB + TAB_META); const int* pair = (const int*)(ws + WS_PAIR) + (size_t)t * 8;
    float acc[8];
    f32x4* op = (f32x4*)(out + (size_t)t * DM + c8); const f32x4 a0 = op[0], a1 = op[1];
    acc[0] = a0.x; acc[1] = a0.y; acc[2] = a0.z; acc[3] = a0.w; acc[4] = a1.x; acc[5] = a1.y; acc[6] = a1.z; acc[7] = a1.w;
#pragma unroll
    for (int k = 0; k < 4; ++k) { const int e = pair[2 * k], slot = pair[2 * k + 1]; const size_t row = (size_t)256 * meta[1 + e] + slot;
        const u32x4 w = *(const u32x4*)((const bf16*)(ws + WS_Y) + row * DM + c8);
        acc[0] += __uint_as_float(w.x << 16); acc[1] += __uint_as_float(w.x & 0xffff0000u); acc[2] += __uint_as_float(w.y << 16); acc[3] += __uint_as_float(w.y & 0xffff0000u);
        acc[4] += __uint_as_float(w.z << 16); acc[5] += __uint_as_float(w.z & 0xffff0000u); acc[6] += __uint_as_float(w.w << 16); acc[7] += __uint_as_float(w.w & 0xffff0000u); }
    op[0] = (f32x4){acc[0], acc[1], acc[2], acc[3]}; op[1] = (f32x4){acc[4], acc[5], acc[6], acc[7]};
}

template <class Epi> struct GemmArgs { pg8::Gemm g; Epi E; const int* meta; int nN, pad; };
template <class Epi> __global__ void __launch_bounds__(512, 2) k_gemm_static(GemmArgs<Epi> a) {
    extern __shared__ __attribute__((aligned(16))) unsigned char lds[];
    pg8::StaticOrder S; S.init(a.g.M, a.g.N, (int)gridDim.x, (int)blockIdx.x);
    pg8::gemm_phase<Epi, pg8::StaticOrder, true, true>((PG8_LAS unsigned char*)lds, a.g, S, a.E);
}
template <class Epi> __global__ void __launch_bounds__(512, 2) k_gemm_moe(GemmArgs<Epi> a) {
    extern __shared__ __attribute__((aligned(16))) unsigned char lds[];
    pg8::MoeOrder S; S.tile_e = a.meta + 64; S.ntiles = a.meta[0]; S.nN = a.nN; S.G = (int)gridDim.x; S.c = (int)blockIdx.x;
    pg8::gemm_phase<Epi, pg8::MoeOrder, true, true>((PG8_LAS unsigned char*)lds, a.g, S, a.E);
}
template <class Epi> static GemmArgs<Epi> mk(const void* A, const void* Bt, int M, int N, int K, const int* meta, int nN) {
    GemmArgs<Epi> a; memset(&a, 0, sizeof(a)); a.g.A = (const pg8::bf16_t*)A; a.g.Bt = (const pg8::bf16_t*)Bt; a.g.M = M; a.g.N = N; a.g.K = K; a.meta = meta; a.nN = nN; return a; }

template <class KERN> static bool set_lds(KERN k) { return hipFuncSetAttribute((const void*)k, hipFuncAttributeMaxDynamicSharedMemorySize, pg8::STAGE_BYTES) == hipSuccess; }
extern "C" void kernel_launch(void* const* d_in, const int* in_sizes, int n_in, void* d_out, int out_size, void* d_ws, size_t ws_size, hipStream_t stream) {
    static int init = 0;
    if (init == 0) {
        init = 1;
        if (n_in != 18 || in_sizes[0] != TOK * DM || out_size != TOK * DM || ws_size < WS_END) { fprintf(stderr, "kernel_launch: unexpected shapes (n_in %d in0 %d out %d ws %zu)\n", n_in, n_in > 0 ? in_sizes[0] : -1, out_size, ws_size); init = -1; }
        bool ok = set_lds(k_gemm_static<pg8::EpiStore>) && set_lds(k_gemm_static<pg8::EpiGate<0>>) && set_lds(k_gemm_static<pg8::EpiGate<1>>) && set_lds(k_gemm_static<pg8::EpiRes>)
               && set_lds(k_gemm_moe<pg8::EpiSwiglu>) && set_lds(k_gemm_moe<pg8::EpiDown>);
        if (!ok) { fprintf(stderr, "kernel_launch: hipFuncSetAttribute failed\n"); init = -1; }
    }
    if (init < 0) return;
    const float* x = (const float*)d_in[0]; const float* g_mix = (const float*)d_in[1]; const float* w_in = (const float*)d_in[2]; const float* b_gate = (const float*)d_in[3];
    const float* qn_a = (const float*)d_in[4]; const float* kn_a = (const float*)d_in[5]; const float* qn_b = (const float*)d_in[6]; const float* kn_b = (const float*)d_in[7];
    const float* w_pa = (const float*)d_in[8]; const float* w_pb = (const float*)d_in[9]; const float* w_out = (const float*)d_in[10]; const float* g_ffn = (const float*)d_in[11];
    const float* w_r = (const float*)d_in[12]; const float* b_r = (const float*)d_in[13]; const float* w_gu = (const float*)d_in[14]; const float* b_gu = (const float*)d_in[15];
    const float* w_d = (const float*)d_in[16]; const float* b_d = (const float*)d_in[17];
    unsigned char* ws = (unsigned char*)d_ws; float* out = (float*)d_out;
    typedef pg8::bf16_t b16;
    (void)hipMemsetAsync(ws + WS_CTL, 0, CTL_ZERO_BYTES, stream);
    k_tables<<<64, 256, 0, stream>>>(qn_a, kn_a, qn_b, kn_b, ws);
    { PrepArgs a{x, g_mix, w_in, w_pa, w_pb, w_out, w_gu, w_d, ws}; k_prep<<<1024, 256, 0, stream>>>(a); }
    const int G = 256, LDSB = pg8::STAGE_BYTES;
    const int* meta = (const int*)(ws + WS_TAB + TAB_META);
    { auto a = mk<pg8::EpiStore>(ws + WS_XN, ws + WS_WIN, TOK, NIN, DM, meta, 0); a.E.O = (b16*)(ws + WS_PROJ); a.E.ldc = NIN; k_gemm_static<pg8::EpiStore><<<G, 512, LDSB, stream>>>(a); }
    { PostArgs a{b_gate, qn_a, kn_a, qn_b, kn_b, ws}; k_post<<<TOK, 256, 0, stream>>>(a); }
    k_attn_a<<<TOK * 8 / 256, 256, 0, stream>>>(ws);
    k_attn_b<<<TOK * 8 / 256, 256, 0, stream>>>(ws);
    { auto a = mk<pg8::EpiGate<0>>(ws + WS_OA, ws + WS_WPA, TOK, DM, 512, meta, 0); a.E.G = (const b16*)(ws + WS_GATES); a.E.TMP = (b16*)(ws + WS_TMP); a.E.OUT = (b16*)(ws + WS_MRG); k_gemm_static<pg8::EpiGate<0>><<<G, 512, LDSB, stream>>>(a); }
    { auto a = mk<pg8::EpiGate<1>>(ws + WS_OB, ws + WS_WPB, TOK, DM, 512, meta, 0); a.E.G = (const b16*)(ws + WS_GATES); a.E.TMP = (b16*)(ws + WS_TMP); a.E.OUT = (b16*)(ws + WS_MRG); k_gemm_static<pg8::EpiGate<1>><<<G, 512, LDSB, stream>>>(a); }
    { auto a = mk<pg8::EpiRes>(ws + WS_MRG, ws + WS_WOUT, TOK, DM, DM, meta, 0); a.E.base = x; a.E.out = out; a.E.ldc = DM; k_gemm_static<pg8::EpiRes><<<G, 512, LDSB, stream>>>(a); }
    { RouteArgs a{out, g_ffn, w_r, b_r, ws}; k_router<<<TOK / 4, 256, 0, stream>>>(a); }
    k_route_fin<<<1, 64, 0, stream>>>(ws);
    k_gather<<<2048, 256, 0, stream>>>(ws);
    { auto a = mk<pg8::EpiSwiglu>(ws + WS_XBUF, ws + WS_WGU, MAXTILES * 256, NEXP * 2048, DM, meta, 8); a.E.bgu = b_gu; a.E.ACT = (b16*)(ws + WS_ACT); k_gemm_moe<pg8::EpiSwiglu><<<G, 512, LDSB, stream>>>(a); }
    { auto a = mk<pg8::EpiDown>(ws + WS_ACT, ws + WS_WD, MAXTILES * 256, NEXP * 1024, DFF, meta, 4); a.E.bd = b_d; a.E.rowgate = (const float*)(ws + WS_ROWG); a.E.Y = (b16*)(ws + WS_Y); k_gemm_moe<pg8::EpiDown><<<G, 512, LDSB, stream>>>(a); }
    k_combine<<<TOK * 128 / 256, 256, 0, stream>>>(out, ws);
}
```

```cpp
#include <hip/hip_runtime.h>
#include <cstdio>
#include <cstdint>
#include <cstring>
constexpr int BATCH = 8, SEQ = 2048, DM = 1024, TOK = BATCH * SEQ;
constexpr int NIN = 7424;
constexpr int NEXP = 32, DFF = 1024, TOPK = 4;
constexpr int MAXTILES = TOK * TOPK / 256 + NEXP;
constexpr int LISTCAP = TOK;
constexpr float EPS = 1e-6f;
constexpr float C2 = 0.125f * 1.4426950408889634f;

typedef unsigned short bf16;
typedef float f32x4 __attribute__((ext_vector_type(4)));
typedef unsigned u32x4 __attribute__((ext_vector_type(4)));
typedef unsigned u32x2 __attribute__((ext_vector_type(2)));
typedef float f32x2v __attribute__((ext_vector_type(2)));
#define LAS __attribute__((address_space(3)))

__device__ __forceinline__ unsigned f2bf(float f) { unsigned u = __builtin_bit_cast(unsigned, f); return (u + 0x7fffu + ((u >> 16) & 1u)) >> 16; }
typedef float f32x2k __attribute__((ext_vector_type(2))); typedef __bf16 bf16x2k __attribute__((ext_vector_type(2)));
__device__ __forceinline__ unsigned pk2(float lo, float hi) { f32x2k v = {lo, hi}; bf16x2k b = __builtin_convertvector(v, bf16x2k); return __builtin_bit_cast(unsigned, b); }
__device__ __forceinline__ float bf2f(bf16 h) { return __uint_as_float((unsigned)h << 16); }
__device__ __forceinline__ float wave_sum(float v) {
#pragma unroll
    for (int o = 1; o < 64; o <<= 1) v += __shfl_xor(v, o);
    return v;
}

__host__ __device__ __forceinline__ int physA(int e) { if (e >= 32) return e; const int fq = e >> 3, n = (e >> 2) & 1, j = e & 3; return j < 2 ? 8 * n + 2 * fq + j : 16 + 4 * fq + 2 * n + (j - 2); }
__host__ __device__ __forceinline__ int physB(int e) { const int b = e & 32, fq = (e >> 3) & 3, n = (e >> 2) & 1, j = e & 3; return b + 16 * n + 4 * fq + j; }
__host__ __device__ __forceinline__ int colmap_in(int np) {
    const int pn = np >> 8, p = np & 255, hw = (p >> 5) & 3, e = ((p >> 7) << 5) | (p & 31);
    if (pn < 6)  return (pn >> 1) * 512 + (4 * (pn & 1) + hw) * 64 + physA(e);
    if (pn < 12) return 1536 + ((pn - 6) >> 1) * 512 + (4 * ((pn - 6) & 1) + hw) * 64 + physA(e);
    if (pn < 18) return 3072 + (pn - 12) * 256 + p;
    if (pn < 20) return 4608 + (4 * (pn - 18) + hw) * 64 + physB(e);
    if (pn == 20) return hw < 2 ? 5120 + hw * 64 + physB(e) : 5248 + (hw - 2) * 64 + e;
    return 5376 + (pn - 21) * 256 + p;
}
__host__ __device__ __forceinline__ int colmap_gu(int np) { const int pn = np >> 8, p = np & 255; return p < 128 ? pn * 128 + p : 1024 + pn * 128 + (p - 128); }

constexpr size_t MiB = 1u << 20;
constexpr size_t WS_CTL = 0;
constexpr size_t CTL_ZERO_BYTES = 1 * MiB;
constexpr size_t WS_TAB = 1 * MiB;
constexpr size_t WS_LIST = 2 * MiB;
constexpr size_t WS_PAIR = 6 * MiB;
constexpr size_t WS_WIN = 8 * MiB;
constexpr size_t WS_WPA = 23 * MiB;
constexpr size_t WS_WPB = 24 * MiB;
constexpr size_t WS_WOUT = 25 * MiB;
constexpr size_t WS_WRT = 27 * MiB;
constexpr size_t WS_WGU = 28 * MiB;
constexpr size_t WS_WD = 156 * MiB;
constexpr size_t WS_XN = 220 * MiB;
constexpr size_t WS_QA = 252 * MiB;
constexpr size_t WS_KA = 300 * MiB;
constexpr size_t WS_VA = 348 * MiB;
constexpr size_t WS_QB = 396 * MiB;
constexpr size_t WS_KB = 412 * MiB;
constexpr size_t WS_VB = 416 * MiB;
constexpr size_t WS_GATES = 420 * MiB;
constexpr size_t WS_OA = 484 * MiB;
constexpr size_t WS_OB = 500 * MiB;
constexpr size_t WS_TMP = 516 * MiB;
constexpr size_t WS_X1 = 516 * MiB;
constexpr size_t WS_MRG = 548 * MiB;
constexpr size_t WS_H2 = 580 * MiB;
constexpr size_t WS_ACT = 756 * MiB;
constexpr size_t WS_Y = 252 * MiB;
constexpr size_t WS_Y2 = 420 * MiB;
constexpr size_t WS_END = 912 * MiB;
constexpr int ACT_PAD = 64, ACT_LD = 1024 + ACT_PAD;
constexpr int CW_CNT = 64;
constexpr size_t TAB_ROPEA = 0;
constexpr size_t TAB_ROW = 128 * 1024;
constexpr size_t TAB_COL = 132 * 1024;
constexpr size_t TAB_SHIFT = 140 * 1024;
constexpr size_t TAB_META = 141 * 1024;

constexpr int NTHR = 512, NWAVES = 8;
constexpr int RING_BYTES = 131072, LDSCTL_OFF = 147456, MISC_OFF = LDSCTL_OFF + 320, META_OFF = LDSCTL_OFF + 1024, LDS_BYTES = 163840;
constexpr int CW_BAR = 4096;
constexpr int CW_QGU = 256, CW_QD = 768, CW_DONE1 = 1280, CW_DONE7 = 1344, CW_RQ = 1536;
__host__ __device__ __forceinline__ int gemm_grid(int units, int G) { const int R = (units + G - 1) / G; int g = R > 0 ? (units + R - 1) / R : G; g = (g + 7) & ~7; return g > G ? G : (g < 8 ? 8 : g); }
constexpr int MT_NT = 0, MT_BASE = 1, MT_CNT = 34, MT_TILE = 96;
constexpr int TOKTAB_OFF = LDSCTL_OFF + 4096, MAXUNITS_GU = (MAXTILES * 8 + 255) / 256 + 1;
static_assert(TOKTAB_OFF + MAXUNITS_GU * 1024 <= LDS_BYTES, "LDS map");
#define RLX_AGENT __ATOMIC_RELAXED, __HIP_MEMORY_SCOPE_AGENT

constexpr int PTR_OFF = LDSCTL_OFF + 512;
__host__ __device__ __forceinline__ int xcd_rank(int b, int G) { return (G % 8 == 0) ? (b % 8) * (G / 8) + b / 8 : b; }
struct Ctx { float* out; unsigned char* ws; LAS unsigned char* lds; int tid, lane, wave, G, bid; };
__device__ __forceinline__ Ctx fresh(const Ctx& C) { Ctx L = C; int t = threadIdx.x; asm volatile("" : "+v"(t)); L.tid = t; L.lane = t & 63; L.wave = __builtin_amdgcn_readfirstlane(t >> 6); return L; }
__device__ __forceinline__ const float* ldptr(const LAS unsigned char* lds, int i) {
    const LAS unsigned* p = (const LAS unsigned*)(lds + PTR_OFF) + 2 * i;
    const unsigned lo = __builtin_amdgcn_readfirstlane(p[0]), hi = __builtin_amdgcn_readfirstlane(p[1]);
    return (const float*)(const __attribute__((address_space(1))) float*)(((unsigned long long)hi << 32) | lo);
}
__device__ __forceinline__ const float* inp(const Ctx& C, int i) {
    const LAS unsigned* p = (const LAS unsigned*)(C.lds + PTR_OFF) + 2 * i;
    const unsigned lo = __builtin_amdgcn_readfirstlane(p[0]), hi = __builtin_amdgcn_readfirstlane(p[1]);
    return (const float*)(const __attribute__((address_space(1))) float*)(((unsigned long long)hi << 32) | lo);
}
enum { I_X = 0, I_GMIX, I_WIN, I_BGATE, I_QNA, I_KNA, I_QNB, I_KNB, I_WPA, I_WPB, I_WOUT, I_GFFN, I_WR, I_BR, I_WGU, I_BGU, I_WD, I_BD };

namespace pg8 {
#define PG8_LAS __attribute__((address_space(3)))
typedef unsigned short bf16_t;
typedef short bf16x8 __attribute__((ext_vector_type(8)));
typedef float f32x4 __attribute__((ext_vector_type(4)));
typedef unsigned u32x4 __attribute__((ext_vector_type(4)));
constexpr int BM = 256, BK = 64, HALF = 128, HTB = HALF * BK * 2  , STAGE_BYTES = 8 * HTB, NXCD = 8, WGM = 8;

__host__ __device__ __forceinline__ int lds_byte(int r, int c) { const int st = (r >> 4) * 2 + (c >> 5), rr = r & 15, cc = c & 31, ob = rr * 64 + cc * 2; return st * 1024 + (ob ^ (((ob >> 9) & 1) << 5)); }
__host__ __device__ __forceinline__ void stage_rc(int b, int& R, int& C) { const int st = b / 1024, sb = b % 1024, swz = sb ^ (((sb >> 9) & 1) << 5); R = (st >> 1) * 16 + swz / 64; C = (st & 1) * 32 + (swz % 64) / 2; }
__host__ __device__ __forceinline__ int perm32(int rho) { const int n = rho >> 4, i = rho & 15; return 8 * (i >> 2) + 4 * n + (i & 3); }

struct Unit { int pm, pn, kh; };
struct Gemm { const bf16_t* A; const bf16_t* Bt; int M, N, K, pad; };

struct StaticOrder {
    int nM, nN, nwg, G, c;
    __host__ __device__ void init(int M, int N, int G_, int c_) { nM = M / BM; nN = N / BM; nwg = nM * nN; G = G_; c = c_; }
    __host__ __device__ bool next(int i, Unit& u) const {
        const long L = (long)i * G + c; if (L >= nwg) return false;
        int wgid = (int)L; { const int q = nwg / NXCD, r = nwg % NXCD, xcd = wgid % NXCD, off = wgid / NXCD; wgid = (xcd < r ? xcd * (q + 1) : r * (q + 1) + (xcd - r) * q) + off; }
        const int nig = WGM * nN, gid = wgid / nig, fm = gid * WGM, gsz = (nM - fm) < WGM ? (nM - fm) : WGM;
        u.pm = fm + ((wgid % nig) % gsz); u.pn = (wgid % nig) / gsz; return true;
    }
    __device__ __forceinline__ void a_ready(const Unit&) const {}
    __device__ __forceinline__ void done(const Unit&) const {}
};

typedef float f32x2c __attribute__((ext_vector_type(2))); typedef __bf16 bf16x2c __attribute__((ext_vector_type(2)));
__device__ __forceinline__ unsigned cvt_pk_bf16(float lo, float hi) { f32x2c v = {lo, hi}; bf16x2c b = __builtin_convertvector(v, bf16x2c); return __builtin_bit_cast(unsigned, b); }
typedef float f32x2 __attribute__((ext_vector_type(2)));
__device__ __forceinline__ void unpack8(const u32x4 w, float (&f)[8]) {
    f[0] = __uint_as_float(w.x << 16); f[1] = __uint_as_float(w.x & 0xffff0000u); f[2] = __uint_as_float(w.y << 16); f[3] = __uint_as_float(w.y & 0xffff0000u);
    f[4] = __uint_as_float(w.z << 16); f[5] = __uint_as_float(w.z & 0xffff0000u); f[6] = __uint_as_float(w.w << 16); f[7] = __uint_as_float(w.w & 0xffff0000u);
}
__device__ __forceinline__ u32x4 pack8(const float (&f)[8]) { u32x4 w; w.x = cvt_pk_bf16(f[0], f[1]); w.y = cvt_pk_bf16(f[2], f[3]); w.z = cvt_pk_bf16(f[4], f[5]); w.w = cvt_pk_bf16(f[6], f[7]); return w; }

struct EpiStore {
    static constexpr bool PERM = true, AFTER_DRAIN = false;
    bf16_t* O; int ldc, pad;
    __device__ __forceinline__ void operator()(const f32x4 (&acc)[2][2][4][2], const Unit& u, int wr, int wc, int fr, int fq) const {
        const int row0 = u.pm * BM + wr * 64 + fr, col0 = u.pn * BM + wc * 32 + 8 * fq;
#pragma unroll
        for (int ai = 0; ai < 2; ++ai)
#pragma unroll
            for (int m = 0; m < 4; ++m) { bf16_t* rowp = O + (size_t)(row0 + ai * HALF + m * 16) * ldc + col0;
#pragma unroll
                for (int bj = 0; bj < 2; ++bj) { const f32x4 v0 = acc[ai][bj][m][0], v1 = acc[ai][bj][m][1];
                    u32x4 w; w.x = cvt_pk_bf16(v0[0], v0[1]); w.y = cvt_pk_bf16(v0[2], v0[3]); w.z = cvt_pk_bf16(v1[0], v1[1]); w.w = cvt_pk_bf16(v1[2], v1[3]);
                    *(u32x4*)(rowp + bj * HALF) = w; } }
    }
};
template <int MODE> struct EpiGate {
    static constexpr bool PERM = true, AFTER_DRAIN = false;
    const bf16_t* G; bf16_t* TMP; bf16_t* OUT;
    __device__ __forceinline__ void operator()(const f32x4 (&acc)[2][2][4][2], const Unit& u, int wr, int wc, int fr, int fq) const {
        const int row0 = u.pm * BM + wr * 64 + fr, col0 = u.pn * BM + wc * 32 + 8 * fq;
#pragma unroll
        for (int ai = 0; ai < 2; ++ai)
#pragma unroll
            for (int m = 0; m < 4; ++m) { const size_t row = (size_t)(row0 + ai * HALF + m * 16);
#pragma unroll
                for (int bj = 0; bj < 2; ++bj) { const int col = col0 + bj * HALF; const f32x4 v0 = acc[ai][bj][m][0], v1 = acc[ai][bj][m][1];
                    float g[8], o[8]; { typedef unsigned u32x2g __attribute__((ext_vector_type(2))); const u32x2g gw = __builtin_nontemporal_load((const u32x2g*)((const unsigned char*)G + row * 2048 + MODE * 1024 + col));
#pragma unroll
                        for (int i = 0; i < 4; ++i) { g[i] = (float)((gw.x >> (8 * i)) & 255u) * (1.0f / 255.0f); g[4 + i] = (float)((gw.y >> (8 * i)) & 255u) * (1.0f / 255.0f); } }
                    const float v[8] = {v0[0], v0[1], v0[2], v0[3], v1[0], v1[1], v1[2], v1[3]};
                    if (MODE == 0) {
#pragma unroll
                        for (int i = 0; i < 8; ++i) o[i] = g[i] * v[i];
                        *(u32x4*)(TMP + row * 1024 + col) = pack8(o);
                    } else { float t[8]; unpack8(*(const u32x4*)(TMP + row * 1024 + col), t);
#pragma unroll
                        for (int i = 0; i < 8; ++i) o[i] = t[i] + g[i] * v[i];
                        *(u32x4*)(OUT + row * 1024 + col) = pack8(o); } } }
    }
};
struct EpiRes {
    static constexpr bool PERM = true, AFTER_DRAIN = false;
    const float* base; bf16_t* out; int ldc, pad;
    __device__ __forceinline__ void operator()(const f32x4 (&acc)[2][2][4][2], const Unit& u, int wr, int wc, int fr, int fq) const {
        const int row0 = u.pm * BM + wr * 64 + fr, col0 = u.pn * BM + wc * 32 + 8 * fq;
#pragma unroll
        for (int ai = 0; ai < 2; ++ai)
#pragma unroll
            for (int m = 0; m < 4; ++m) { const size_t off = (size_t)(row0 + ai * HALF + m * 16) * ldc + col0;
#pragma unroll
                for (int bj = 0; bj < 2; ++bj) { const f32x4 b0 = __builtin_nontemporal_load((const f32x4*)(base + off + bj * HALF)), b1 = __builtin_nontemporal_load((const f32x4*)(base + off + bj * HALF + 4));
                    const f32x4 v0 = b0 + acc[ai][bj][m][0], v1 = b1 + acc[ai][bj][m][1];
                    u32x4 w; w.x = cvt_pk_bf16(v0[0], v0[1]); w.y = cvt_pk_bf16(v0[2], v0[3]); w.z = cvt_pk_bf16(v1[0], v1[1]); w.w = cvt_pk_bf16(v1[2], v1[3]);
                    *(u32x4*)(out + off + bj * HALF) = w; } }
    }
};
struct EpiSwiglu {
    static constexpr bool PERM = true, AFTER_DRAIN = false;
    const float* bgu; bf16_t* ACT;
    __device__ __forceinline__ void operator()(const f32x4 (&acc)[2][2][4][2], const Unit& u, int wr, int wc, int fr, int fq) const {
        const int e = u.pn >> 3, pnl = u.pn & 7, colh = pnl * 128 + wc * 32 + 8 * fq, row0 = u.pm * BM + wr * 64 + fr;
        const float* bg = bgu + (size_t)e * 2048 + colh; const float* bu = bg + 1024;
        const f32x4 bg0 = *(const f32x4*)bg, bg1 = *(const f32x4*)(bg + 4), bu0 = *(const f32x4*)bu, bu1 = *(const f32x4*)(bu + 4);
#pragma unroll
        for (int ai = 0; ai < 2; ++ai)
#pragma unroll
            for (int m = 0; m < 4; ++m) { const size_t row = (size_t)(row0 + ai * HALF + m * 16);
                const f32x4 g0 = acc[ai][0][m][0] + bg0, g1 = acc[ai][0][m][1] + bg1, u0 = acc[ai][1][m][0] + bu0, u1 = acc[ai][1][m][1] + bu1;
                const float gv[8] = {g0[0], g0[1], g0[2], g0[3], g1[0], g1[1], g1[2], g1[3]}, uv[8] = {u0[0], u0[1], u0[2], u0[3], u1[0], u1[1], u1[2], u1[3]};
                float o[8];
#pragma unroll
                for (int i = 0; i < 8; ++i) { const float gate = fminf(gv[i], 7.0f), up = fminf(fmaxf(uv[i], -7.0f), 7.0f);
                    const float sg = __builtin_amdgcn_rcpf(1.0f + __builtin_amdgcn_exp2f(gate * (-1.702f * 1.4426950408889634f)));
                    o[i] = (up + 1.0f) * (gate * sg); }
                *(u32x4*)(ACT + row * ACT_LD + colh) = pack8(o); }
    }
};
struct EpiDown {
    static constexpr bool PERM = true, AFTER_DRAIN = false;
    const float* bd; const int* list; const PG8_LAS int* meta; bf16_t* Y; bf16_t* Y2; int row2;
    __device__ __forceinline__ void operator()(const f32x4 (&acc)[2][2][4][2], const Unit& u, int wr, int wc, int fr, int fq) const {
        const int e = u.pn >> 2, pnl = u.pn & 3, col0 = pnl * 256 + wc * 32 + 8 * fq, rl0 = wr * 64 + fr, slot0 = 256 * (u.pm - meta[MT_BASE + e]), cnt = meta[MT_CNT + e];
        f32x4 b[2][2];
#pragma unroll
        for (int bj = 0; bj < 2; ++bj)
#pragma unroll
            for (int n = 0; n < 2; ++n) b[bj][n] = u.kh == 2 ? (f32x4){0.f, 0.f, 0.f, 0.f} : *(const f32x4*)(bd + (size_t)e * 1024 + col0 + bj * HALF + 4 * n);
        bf16_t* const Yo = u.kh == 2 ? Y2 - (size_t)row2 * 1024 : Y;
        float rg[2][4];
#pragma unroll
        for (int ai = 0; ai < 2; ++ai)
#pragma unroll
            for (int m = 0; m < 4; ++m) { const int slot = slot0 + rl0 + ai * HALF + m * 16; rg[ai][m] = slot < cnt ? __int_as_float(list[((size_t)e * LISTCAP + slot) * 2 + 1]) : 0.f; }
#pragma unroll
        for (int ai = 0; ai < 2; ++ai)
#pragma unroll
            for (int m = 0; m < 4; ++m) { const size_t row = (size_t)(u.pm * BM + rl0 + ai * HALF + m * 16); const float g = rg[ai][m];
#pragma unroll
                for (int bj = 0; bj < 2; ++bj) { const f32x4 v0 = (acc[ai][bj][m][0] + b[bj][0]) * g, v1 = (acc[ai][bj][m][1] + b[bj][1]) * g;
                    u32x4 w; w.x = cvt_pk_bf16(v0[0], v0[1]); w.y = cvt_pk_bf16(v0[2], v0[3]); w.z = cvt_pk_bf16(v1[0], v1[1]); w.w = cvt_pk_bf16(v1[2], v1[3]);
                    *(u32x4*)(Yo + row * 1024 + col0 + bj * HALF) = w; } }
    }
};
struct MoeOrder {
    const PG8_LAS int* tile_e; int ntiles, nN, G, c;
    __device__ __forceinline__ bool next(int i, Unit& u) const {
        const long L = (long)i * G + c; if (L >= (long)ntiles * nN) return false;
        const int t = (int)(L / nN), pnl = (int)(L % nN); u.pm = t; u.pn = tile_e[t] * nN + pnl; u.kh = 0; return true; }
    __device__ __forceinline__ void a_ready(const Unit&) const {}
    __device__ __forceinline__ void done(const Unit&) const {}
};
__host__ __device__ __forceinline__ int moe_split_full(int nunits, int G) { const int full = (nunits / G) * G, rem = nunits - full; return (rem > 0 && 2 * rem <= G) ? full : nunits; }
struct MoeSplitOrder {
    const PG8_LAS int* tile_e; int ntiles, nN, G, c;
    __device__ __forceinline__ bool next(int i, Unit& u) const {
        const int nunits = ntiles * nN, full = moe_split_full(nunits, G); long L = (long)i * G + c; int kh = 0;
        if (L >= full) { const long j = L - full; L = full + (j >> 1); kh = 1 + (int)(j & 1); }
        if (L >= nunits) return false;
        const int t = (int)(L / nN), pnl = (int)(L % nN); u.pm = t; u.pn = tile_e[t] * nN + pnl; u.kh = kh; return true; }
    __device__ __forceinline__ void a_ready(const Unit&) const {}
    __device__ __forceinline__ void done(const Unit&) const {}
};
struct EpiInProj {
    static constexpr bool PERM = true, AFTER_DRAIN = false;
    const LAS unsigned char* lds; unsigned char* ws;
    static __device__ __forceinline__ size_t arow(int row, int lg) { const int t = row & (SEQ - 1); return ((size_t)(row >> 11) * (24 * 2048) + (size_t)(((t & ((1 << lg) - 1)) << (11 - lg)) + (t >> lg))) * 64; }
    template <int ROPE> __device__ __forceinline__ void norm_rope(const f32x4 (&acc)[2][2][4][2], int row0, int fq, const float* gain, float scale, bf16_t* dst, int ld, int lg = -1) const {
        float gv[2][2][4];
#pragma unroll
        for (int bj = 0; bj < 2; ++bj)
#pragma unroll
            for (int n = 0; n < 2; ++n)
#pragma unroll
                for (int j = 0; j < 4; ++j) { const int e = 32 * bj + 8 * fq + 4 * n + j; gv[bj][n][j] = gain[ROPE == 0 ? physA(e) : physB(e)] * scale; }
        const f32x2v* ropeA = (const f32x2v*)(ws + WS_TAB + TAB_ROPEA); const f32x2v* rowt = (const f32x2v*)(ws + WS_TAB + TAB_ROW); const f32x2v* colt = (const f32x2v*)(ws + WS_TAB + TAB_COL);
#pragma unroll
        for (int ai = 0; ai < 2; ++ai)
#pragma unroll
            for (int m = 0; m < 4; ++m) { const int row = row0 + ai * HALF + m * 16, t = row & (SEQ - 1);
                float y[2][2][4]; float ss = 0.f;
#pragma unroll
                for (int bj = 0; bj < 2; ++bj)
#pragma unroll
                    for (int n = 0; n < 2; ++n)
#pragma unroll
                        for (int j = 0; j < 4; ++j) { const float v = acc[ai][bj][m][n][j]; y[bj][n][j] = v; ss += v * v; }
                ss += __shfl_xor(ss, 16); ss += __shfl_xor(ss, 32);
                const float rstd = 1.f / sqrtf(ss * (1.f / 64.f) + EPS);
#pragma unroll
                for (int bj = 0; bj < 2; ++bj)
#pragma unroll
                    for (int n = 0; n < 2; ++n)
#pragma unroll
                        for (int j = 0; j < 4; ++j) y[bj][n][j] *= rstd * gv[bj][n][j];
                if (ROPE == 0) { const f32x4 cs = *(const f32x4*)(ropeA + t * 8 + 2 * fq);
                    { const float a = y[0][0][0], b = y[0][1][0]; y[0][0][0] = a * cs.x - b * cs.y; y[0][1][0] = b * cs.x + a * cs.y; }
                    { const float a = y[0][0][1], b = y[0][1][1]; y[0][0][1] = a * cs.z - b * cs.w; y[0][1][1] = b * cs.z + a * cs.w; }
                } else {
#pragma unroll
                    for (int bj = 0; bj < 2; ++bj) { const f32x2v* tab = (bj == 0 ? rowt + (t >> 6) * 16 : colt + (t & 63) * 16) + 4 * fq; const f32x4 c01 = *(const f32x4*)tab, c23 = *(const f32x4*)(tab + 2);
                        const float cc[4] = {c01.x, c01.z, c23.x, c23.z}, sn[4] = {c01.y, c01.w, c23.y, c23.w};
#pragma unroll
                        for (int j = 0; j < 4; ++j) { const float a = y[bj][0][j], b = y[bj][1][j]; y[bj][0][j] = a * cc[j] - b * sn[j]; y[bj][1][j] = b * cc[j] + a * sn[j]; } }
                }
#pragma unroll
                for (int bj = 0; bj < 2; ++bj) { u32x4 w; w.x = cvt_pk_bf16(y[bj][0][0], y[bj][0][1]); w.y = cvt_pk_bf16(y[bj][0][2], y[bj][0][3]); w.z = cvt_pk_bf16(y[bj][1][0], y[bj][1][1]); w.w = cvt_pk_bf16(y[bj][1][2], y[bj][1][3]);
                    *(u32x4*)(dst + (lg < 0 ? (size_t)row * ld : arow(row, lg)) + 32 * bj + 8 * fq) = w; } }
    }
    __device__ __forceinline__ void plain(const f32x4 (&acc)[2][2][4][2], int row0, bf16_t* dst, int ld, int colstep) const {
#pragma unroll
        for (int ai = 0; ai < 2; ++ai)
#pragma unroll
            for (int m = 0; m < 4; ++m) { bf16_t* rowp = dst + (size_t)(row0 + ai * HALF + m * 16) * ld;
#pragma unroll
                for (int bj = 0; bj < 2; ++bj) { const f32x4 v0 = acc[ai][bj][m][0], v1 = acc[ai][bj][m][1];
                    u32x4 w; w.x = cvt_pk_bf16(v0[0], v0[1]); w.y = cvt_pk_bf16(v0[2], v0[3]); w.z = cvt_pk_bf16(v1[0], v1[1]); w.w = cvt_pk_bf16(v1[2], v1[3]);
                    *(u32x4*)(rowp + bj * colstep) = w; } }
    }
    __device__ __forceinline__ void operator()(const f32x4 (&acc)[2][2][4][2], const Unit& u, int wr, int wc, int fr, int fq) const {
        const int pn = u.pn, row0 = u.pm * BM + wr * 64 + fr;
        if (pn < 12) {
            const int isk = pn >= 6, v = isk ? pn - 6 : pn, g = v >> 1, head = 4 * (v & 1) + wc;
            bf16_t* dst = (bf16_t*)(ws + (isk ? WS_KA : WS_QA)) + (size_t)(g * 8 + head) * (2048 * 64);
            norm_rope<0>(acc, row0, fq, ldptr(lds, isk ? I_KNA : I_QNA) + g * 64, isk ? 1.f : C2, dst, 0, 2 * g);
        } else if (pn < 18) {
            { const int g = (pn - 12) >> 1, head = ((pn - 12) & 1) * 4 + (wc >> 1), lg = 2 * g;
              bf16_t* dst = (bf16_t*)(ws + WS_VA) + (size_t)(g * 8 + head) * (2048 * 64) + (wc & 1) * 32 + 8 * fq;
#pragma unroll
              for (int ai = 0; ai < 2; ++ai)
#pragma unroll
                for (int m = 0; m < 4; ++m) { bf16_t* rowp = dst + arow(row0 + ai * HALF + m * 16, lg);
#pragma unroll
                    for (int bj = 0; bj < 2; ++bj) { const f32x4 v0 = acc[ai][bj][m][0], v1 = acc[ai][bj][m][1];
                        u32x4 w; w.x = cvt_pk_bf16(v0[0], v0[1]); w.y = cvt_pk_bf16(v0[2], v0[3]); w.z = cvt_pk_bf16(v1[0], v1[1]); w.w = cvt_pk_bf16(v1[2], v1[3]);
                        *(u32x4*)(rowp + (size_t)bj * 2 * (2048 * 64)) = w; } } }
        } else if (pn < 20) {
            norm_rope<1>(acc, row0, fq, ldptr(lds, I_QNB), C2, (bf16_t*)(ws + WS_QB) + (4 * (pn - 18) + wc) * 64, 512);
        } else if (pn == 20) {
            if (wc < 2) norm_rope<1>(acc, row0, fq, ldptr(lds, I_KNB), 1.f, (bf16_t*)(ws + WS_KB) + wc * 64, 128);
            else plain(acc, row0, (bf16_t*)(ws + WS_VB) + (wc - 2) * 64 + 8 * fq, 128, 32);
        } else {
            const int col0 = (pn - 21) * 256 + wc * 32 + 8 * fq; unsigned char* G = (unsigned char*)(ws + WS_GATES); const float* b_gate = ldptr(lds, I_BGATE);
            f32x4 bv[2][2];
#pragma unroll
            for (int bj = 0; bj < 2; ++bj)
#pragma unroll
                for (int n = 0; n < 2; ++n) bv[bj][n] = *(const f32x4*)(b_gate + col0 + bj * HALF + 4 * n);
#pragma unroll
            for (int ai = 0; ai < 2; ++ai)
#pragma unroll
                for (int m = 0; m < 4; ++m) { unsigned char* rowp = G + (size_t)(row0 + ai * HALF + m * 16) * 2048 + col0;
#pragma unroll
                    for (int bj = 0; bj < 2; ++bj) { const f32x4 z0 = acc[ai][bj][m][0] + bv[bj][0], z1 = acc[ai][bj][m][1] + bv[bj][1];
                        const float z[8] = {z0[0], z0[1], z0[2], z0[3], z1[0], z1[1], z1[2], z1[3]}; unsigned q[8];
#pragma unroll
                        for (int i = 0; i < 8; ++i) q[i] = (unsigned)(255.0f * __builtin_amdgcn_rcpf(1.0f + __builtin_amdgcn_exp2f(z[i] * -1.4426950408889634f)) + 0.5f);
                        typedef unsigned u32x2g __attribute__((ext_vector_type(2)));
                        const u32x2g w = {q[0] | (q[1] << 8) | (q[2] << 16) | (q[3] << 24), q[4] | (q[5] << 8) | (q[6] << 16) | (q[7] << 24)};
                        __builtin_nontemporal_store(w, (u32x2g*)(rowp + bj * HALF)); } }
        }
    }
};
template <class Epi, class Sched, bool ALIGN_EPI = false, bool SP2 = false, bool KSPLIT = false>
__device__ __forceinline__ void gemm_phase(PG8_LAS unsigned char* lds, const Gemm g, const Sched& S, const Epi& E) {
    int tid_ = threadIdx.x; asm volatile("" : "+v"(tid_));
    const int tid = tid_, wid = __builtin_amdgcn_readfirstlane(tid >> 6), lane = tid & 63, wr = wid >> 2, wc = wid & 3, fr = lane & 15, fq = lane >> 4;
    const int K = g.K, nt = K / BK;
    unsigned voffA[2], voffB[2];
#pragma unroll
    for (int i = 0; i < 2; ++i) { int R, C; stage_rc(tid * 16 + i * 8192, R, C); const int Rb = Epi::PERM ? ((R & ~31) + perm32(R & 31)) : R;
        voffA[i] = (unsigned)(R * (K + g.pad) + C) * 2u; voffB[i] = (unsigned)(Rb * K + C) * 2u; }
    const size_t kstep = (size_t)(BK * 2);
    const size_t hstep = (size_t)HALF * K * 2;
    const size_t tstep = 2 * hstep;
    const size_t hstepA = (size_t)HALF * (K + g.pad) * 2, tstepA = 2 * hstepA;
    const unsigned ldsw = (unsigned)wid * 1024u;
    const int aoff = lds_byte(wr * 64 + fr, fq * 8), boff = lds_byte(wc * 32 + fr, fq * 8);
#define PG8_SA(b, h) (((b) * 2 + (h)) * HTB)
#define PG8_SB(b, h) ((4 + (b) * 2 + (h)) * HTB)
#define PG8_STAGE(bufoff, gbase, voff) do { _Pragma("unroll") for (int _i = 0; _i < 2; ++_i) \
        __builtin_amdgcn_global_load_lds((const unsigned*)((const char*)(gbase) + (voff)[_i]), (PG8_LAS unsigned*)(lds + (bufoff) + ldsw + _i * 8192), 16, 0, 0); } while (0)
#define PG8_LDA(dst, b, h) do { _Pragma("unroll") for (int m = 0; m < 4; ++m) _Pragma("unroll") for (int k = 0; k < 2; ++k) dst[m][k] = *(const PG8_LAS bf16x8*)(lds + PG8_SA(b, h) + aoff + m * 2048 + k * 1024); } while (0)
#define PG8_LDB(dst, b, h) do { _Pragma("unroll") for (int n = 0; n < 2; ++n) _Pragma("unroll") for (int k = 0; k < 2; ++k) dst[n][k] = *(const PG8_LAS bf16x8*)(lds + PG8_SB(b, h) + boff + n * 2048 + k * 1024); } while (0)
#define PG8_MMA(ai, bj, At, Bt) do { __builtin_amdgcn_s_setprio(1); _Pragma("unroll") for (int m = 0; m < 4; ++m) _Pragma("unroll") for (int n = 0; n < 2; ++n) _Pragma("unroll") for (int k = 0; k < 2; ++k) \
        acc[ai][bj][m][n] = __builtin_amdgcn_mfma_f32_16x16x32_bf16(Bt[n][k], At[m][k], acc[ai][bj][m][n], 0, 0, 0); __builtin_amdgcn_s_setprio(0); } while (0)
#define PG8_WAIT_V(n) asm volatile("s_waitcnt vmcnt(" #n ")" ::: "memory")
#define PG8_WAIT_L(n) asm volatile("s_waitcnt lgkmcnt(" #n ")" ::: "memory")
#define PG8_BAR __builtin_amdgcn_s_barrier()
#define PG8_SCHED __builtin_amdgcn_sched_barrier(0)
    Unit cur, nxt; int ui = 0;
    if (!S.next(0, cur)) return;
    f32x4 acc[2][2][4][2];
#pragma unroll
    for (int a = 0; a < 2; ++a)
#pragma unroll
        for (int b = 0; b < 2; ++b)
#pragma unroll
            for (int m = 0; m < 4; ++m)
#pragma unroll
                for (int n = 0; n < 2; ++n) acc[a][b][m][n] = (f32x4){0.f, 0.f, 0.f, 0.f};
    bf16x8 At[4][2], B0[2][2], B1[2][2];
    const size_t khoff = (size_t)(K / 2) * 2;
    int ntc = nt; if constexpr (KSPLIT) ntc = cur.kh ? nt / 2 : nt;
    const char* cA = (const char*)g.A + (size_t)cur.pm * tstepA; const char* cB = (const char*)g.Bt + (size_t)cur.pn * tstep;
    if constexpr (KSPLIT) { if (cur.kh == 2) { cA += khoff; cB += khoff; } }
    S.a_ready(cur);
    if constexpr (SP2) {
        PG8_STAGE(PG8_SB(0, 0), cB, voffB); PG8_STAGE(PG8_SB(0, 1), cB + hstep, voffB); PG8_STAGE(PG8_SA(0, 0), cA, voffA); PG8_STAGE(PG8_SA(0, 1), cA + hstepA, voffA);
        if (wr == 1) PG8_BAR;
        PG8_WAIT_V(2); PG8_BAR;
        PG8_STAGE(PG8_SB(1, 0), cB + kstep, voffB); PG8_STAGE(PG8_SA(1, 0), cA + kstep, voffA); PG8_STAGE(PG8_SB(1, 1), cB + hstep + kstep, voffB);
        PG8_WAIT_V(6); PG8_BAR;
    } else {
        PG8_STAGE(PG8_SB(0, 0), cB, voffB); PG8_STAGE(PG8_SA(0, 0), cA, voffA); PG8_STAGE(PG8_SB(0, 1), cB + hstep, voffB); PG8_STAGE(PG8_SA(0, 1), cA + hstepA, voffA);
        if (wr == 1) PG8_BAR;
        PG8_WAIT_V(4); PG8_BAR;
        PG8_STAGE(PG8_SB(1, 0), cB + kstep, voffB); PG8_STAGE(PG8_SA(1, 0), cA + kstep, voffA); PG8_STAGE(PG8_SB(1, 1), cB + hstep + kstep, voffB);
        PG8_WAIT_V(6); PG8_BAR;
    }
    for (;;) {
        const bool has_next = S.next(ui + 1, nxt);
        const char* nA = has_next ? (const char*)g.A + (size_t)nxt.pm * tstepA : cA; const char* nB = has_next ? (const char*)g.Bt + (size_t)nxt.pn * tstep : cB;
        if constexpr (KSPLIT) { if (has_next && nxt.kh == 2) { nA += khoff; nB += khoff; } }
        for (int t = 0; t < ntc; t += 2) {
            const bool last = (t == ntc - 2);
            const char* a1 = cA + (size_t)(t + 1) * kstep;
            const char* a2 = last ? nA : cA + (size_t)(t + 2) * kstep; const char* b2 = last ? nB : cB + (size_t)(t + 2) * kstep;
            const char* a3 = a2 + kstep; const char* b3 = b2 + kstep;
            if (last && has_next) S.a_ready(nxt);
            if constexpr (SP2) {
            PG8_LDB(B0, 0, 0); PG8_LDB(B1, 0, 1); PG8_SCHED; PG8_LDA(At, 0, 0); PG8_STAGE(PG8_SA(1, 1), a1 + hstepA, voffA);
            PG8_WAIT_V(8); PG8_WAIT_L(0); PG8_BAR; PG8_MMA(0, 0, At, B0); PG8_MMA(0, 1, At, B1); PG8_BAR; PG8_SCHED;
            PG8_LDA(At, 0, 1); PG8_STAGE(PG8_SB(0, 0), b2, voffB); PG8_STAGE(PG8_SB(0, 1), b2 + hstep, voffB); PG8_STAGE(PG8_SA(0, 0), a2, voffA);
            PG8_WAIT_V(8); PG8_WAIT_L(0); PG8_BAR; PG8_MMA(1, 0, At, B0); PG8_MMA(1, 1, At, B1); PG8_BAR; PG8_SCHED;
            PG8_LDB(B0, 1, 0); PG8_LDB(B1, 1, 1); PG8_SCHED; PG8_LDA(At, 1, 0); PG8_STAGE(PG8_SA(0, 1), a2 + hstepA, voffA);
            PG8_WAIT_V(8); PG8_WAIT_L(0); PG8_BAR; PG8_MMA(0, 0, At, B0); PG8_MMA(0, 1, At, B1); PG8_BAR; PG8_SCHED;
            PG8_LDA(At, 1, 1); PG8_STAGE(PG8_SB(1, 0), b3, voffB); PG8_STAGE(PG8_SB(1, 1), b3 + hstep, voffB); PG8_STAGE(PG8_SA(1, 0), a3, voffA);
            PG8_WAIT_V(8); PG8_WAIT_L(0); PG8_BAR; PG8_MMA(1, 0, At, B0); PG8_MMA(1, 1, At, B1); PG8_BAR; PG8_SCHED;
            } else {
            PG8_LDB(B0, 0, 0); PG8_SCHED; PG8_LDA(At, 0, 0); PG8_STAGE(PG8_SA(1, 1), a1 + hstepA, voffA);
            PG8_WAIT_L(8); PG8_BAR; PG8_WAIT_L(0); PG8_MMA(0, 0, At, B0); PG8_BAR; PG8_SCHED;
            PG8_LDB(B1, 0, 1); PG8_STAGE(PG8_SB(0, 0), b2, voffB);
            PG8_BAR; PG8_WAIT_L(0); PG8_MMA(0, 1, At, B1); PG8_BAR;
            PG8_LDA(At, 0, 1); PG8_STAGE(PG8_SA(0, 0), a2, voffA);
            PG8_BAR; PG8_WAIT_L(0); PG8_MMA(1, 0, At, B0); PG8_BAR; PG8_SCHED;
            PG8_STAGE(PG8_SB(0, 1), b2 + hstep, voffB);
            PG8_WAIT_V(6); PG8_BAR; PG8_MMA(1, 1, At, B1); PG8_BAR;
            PG8_LDB(B0, 1, 0); PG8_SCHED; PG8_LDA(At, 1, 0); PG8_STAGE(PG8_SA(0, 1), a2 + hstepA, voffA);
            PG8_WAIT_L(8); PG8_BAR; PG8_WAIT_L(0); PG8_MMA(0, 0, At, B0); PG8_BAR; PG8_SCHED;
            PG8_LDB(B1, 1, 1); PG8_STAGE(PG8_SB(1, 0), b3, voffB);
            PG8_BAR; PG8_WAIT_L(0); PG8_MMA(0, 1, At, B1); PG8_BAR;
            PG8_LDA(At, 1, 1); PG8_STAGE(PG8_SA(1, 0), a3, voffA);
            PG8_BAR; PG8_WAIT_L(0); PG8_MMA(1, 0, At, B0); PG8_BAR; PG8_SCHED;
            PG8_STAGE(PG8_SB(1, 1), b3 + hstep, voffB);
            PG8_WAIT_V(6); PG8_BAR; PG8_MMA(1, 1, At, B1); PG8_BAR;
            }
        }
        if constexpr (ALIGN_EPI) { if (wr == 0) PG8_BAR; }
        if constexpr (!Epi::AFTER_DRAIN) { E(acc, cur, wr, wc, fr, fq); S.done(cur); }
        if (!has_next) break;
#pragma unroll
        for (int a = 0; a < 2; ++a)
#pragma unroll
            for (int b = 0; b < 2; ++b)
#pragma unroll
                for (int m = 0; m < 4; ++m)
#pragma unroll
                    for (int n = 0; n < 2; ++n) acc[a][b][m][n] = (f32x4){0.f, 0.f, 0.f, 0.f};
        cur = nxt; cA = nA; cB = nB; ++ui; if constexpr (KSPLIT) ntc = cur.kh ? nt / 2 : nt;
        if constexpr (ALIGN_EPI) { if (wr == 1) PG8_BAR; }
    }
    PG8_WAIT_V(0);
    if constexpr (!ALIGN_EPI) { if (wr == 0) PG8_BAR; }
    PG8_BAR;
    if constexpr (Epi::AFTER_DRAIN) { E.fused(acc, cur, wr, wc, fr, fq, lds, wid, lane); S.done(cur); }
#undef PG8_SA
#undef PG8_SB
#undef PG8_STAGE
#undef PG8_LDA
#undef PG8_LDB
#undef PG8_MMA
#undef PG8_WAIT_V
#undef PG8_WAIT_L
#undef PG8_BAR
#undef PG8_SCHED
}

template <class Epi, class Sched>
__device__ __forceinline__ void gemm_phase_gather(PG8_LAS unsigned char* lds, const Gemm g, const Sched& S, const Epi& E, const PG8_LAS int* tokTab) {
    int tid_ = threadIdx.x; asm volatile("" : "+v"(tid_));
    const int tid = tid_, wid = __builtin_amdgcn_readfirstlane(tid >> 6), lane = tid & 63, wr = wid >> 2, wc = wid & 3, fr = lane & 15, fq = lane >> 4;
    const int K = g.K, nt = K / BK;
    unsigned voffB[2]; int RA[2], CA[2];
#pragma unroll
    for (int i = 0; i < 2; ++i) { int R, C; stage_rc(tid * 16 + i * 8192, R, C); const int Rb = Epi::PERM ? ((R & ~31) + perm32(R & 31)) : R;
        RA[i] = R; CA[i] = C * 2; voffB[i] = (unsigned)(Rb * K + C) * 2u; }
    unsigned cv0[2], cv1[2], nv0[2], nv1[2];
#define PG8_TOKS(v0, v1, u) do { _Pragma("unroll") for (int _i = 0; _i < 2; ++_i) { v0[_i] = (unsigned)tokTab[(u) * 256 + RA[_i]] * (unsigned)(K * 2) + (unsigned)CA[_i]; v1[_i] = (unsigned)tokTab[(u) * 256 + 128 + RA[_i]] * (unsigned)(K * 2) + (unsigned)CA[_i]; } } while (0)
    const size_t kstep = (size_t)(BK * 2);
    const size_t hstep = (size_t)HALF * K * 2;
    const size_t tstep = 2 * hstep;
    const unsigned ldsw = (unsigned)wid * 1024u;
    const int aoff = lds_byte(wr * 64 + fr, fq * 8), boff = lds_byte(wc * 32 + fr, fq * 8);
#define PG8_SA(b, h) (((b) * 2 + (h)) * HTB)
#define PG8_SB(b, h) ((4 + (b) * 2 + (h)) * HTB)
#define PG8_STAGE(bufoff, gbase, voff) do { _Pragma("unroll") for (int _i = 0; _i < 2; ++_i) \
        __builtin_amdgcn_global_load_lds((const unsigned*)((const char*)(gbase) + (voff)[_i]), (PG8_LAS unsigned*)(lds + (bufoff) + ldsw + _i * 8192), 16, 0, 0); } while (0)
#define PG8_LDA(dst, b, h) do { _Pragma("unroll") for (int m = 0; m < 4; ++m) _Pragma("unroll") for (int k = 0; k < 2; ++k) dst[m][k] = *(const PG8_LAS bf16x8*)(lds + PG8_SA(b, h) + aoff + m * 2048 + k * 1024); } while (0)
#define PG8_LDB(dst, b, h) do { _Pragma("unroll") for (int n = 0; n < 2; ++n) _Pragma("unroll") for (int k = 0; k < 2; ++k) dst[n][k] = *(const PG8_LAS bf16x8*)(lds + PG8_SB(b, h) + boff + n * 2048 + k * 1024); } while (0)
#define PG8_MMA(ai, bj, At, Bt) do { __builtin_amdgcn_s_setprio(1); _Pragma("unroll") for (int m = 0; m < 4; ++m) _Pragma("unroll") for (int n = 0; n < 2; ++n) _Pragma("unroll") for (int k = 0; k < 2; ++k) \
        acc[ai][bj][m][n] = __builtin_amdgcn_mfma_f32_16x16x32_bf16(Bt[n][k], At[m][k], acc[ai][bj][m][n], 0, 0, 0); __builtin_amdgcn_s_setprio(0); } while (0)
#define PG8_WAIT_V(n) asm volatile("s_waitcnt vmcnt(" #n ")" ::: "memory")
#define PG8_WAIT_L(n) asm volatile("s_waitcnt lgkmcnt(" #n ")" ::: "memory")
#define PG8_BAR __builtin_amdgcn_s_barrier()
#define PG8_SCHED __builtin_amdgcn_sched_barrier(0)
    Unit cur, nxt; int ui = 0;
    if (!S.next(0, cur)) return;
    f32x4 acc[2][2][4][2];
#pragma unroll
    for (int a = 0; a < 2; ++a)
#pragma unroll
        for (int b = 0; b < 2; ++b)
#pragma unroll
            for (int m = 0; m < 4; ++m)
#pragma unroll
                for (int n = 0; n < 2; ++n) acc[a][b][m][n] = (f32x4){0.f, 0.f, 0.f, 0.f};
    bf16x8 At[4][2], B0[2][2], B1[2][2];
    const char* const cA = (const char*)g.A; const char* cB = (const char*)g.Bt + (size_t)cur.pn * tstep;
    PG8_TOKS(cv0, cv1, 0);
    PG8_STAGE(PG8_SB(0, 0), cB, voffB); PG8_STAGE(PG8_SB(0, 1), cB + hstep, voffB); PG8_STAGE(PG8_SA(0, 0), cA, cv0); PG8_STAGE(PG8_SA(0, 1), cA, cv1);
    if (wr == 1) PG8_BAR;
    PG8_WAIT_V(2); PG8_BAR;
    PG8_STAGE(PG8_SB(1, 0), cB + kstep, voffB); PG8_STAGE(PG8_SA(1, 0), cA + kstep, cv0); PG8_STAGE(PG8_SB(1, 1), cB + hstep + kstep, voffB);
    PG8_WAIT_V(6); PG8_BAR;
    for (;;) {
        const bool has_next = S.next(ui + 1, nxt);
        if (has_next) PG8_TOKS(nv0, nv1, ui + 1); else { nv0[0] = cv0[0]; nv0[1] = cv0[1]; nv1[0] = cv1[0]; nv1[1] = cv1[1]; }
        const char* nB = has_next ? (const char*)g.Bt + (size_t)nxt.pn * tstep : cB;
        for (int t = 0; t < nt; t += 2) {
            const bool last = (t == nt - 2);
            const char* a1 = cA + (size_t)(t + 1) * kstep;
            const char* a2 = last ? cA : cA + (size_t)(t + 2) * kstep; const char* b2 = last ? nB : cB + (size_t)(t + 2) * kstep;
            const char* a3 = a2 + kstep; const char* b3 = b2 + kstep;
            unsigned x0[2], x1[2];
            x0[0] = last ? nv0[0] : cv0[0]; x0[1] = last ? nv0[1] : cv0[1]; x1[0] = last ? nv1[0] : cv1[0]; x1[1] = last ? nv1[1] : cv1[1];
            PG8_LDB(B0, 0, 0); PG8_LDB(B1, 0, 1); PG8_SCHED; PG8_LDA(At, 0, 0); PG8_STAGE(PG8_SA(1, 1), a1, cv1);
            PG8_WAIT_V(8); PG8_WAIT_L(0); PG8_BAR; PG8_MMA(0, 0, At, B0); PG8_MMA(0, 1, At, B1); PG8_BAR; PG8_SCHED;
            PG8_LDA(At, 0, 1); PG8_STAGE(PG8_SB(0, 0), b2, voffB); PG8_STAGE(PG8_SB(0, 1), b2 + hstep, voffB); PG8_STAGE(PG8_SA(0, 0), a2, x0);
            PG8_WAIT_V(8); PG8_WAIT_L(0); PG8_BAR; PG8_MMA(1, 0, At, B0); PG8_MMA(1, 1, At, B1); PG8_BAR; PG8_SCHED;
            PG8_LDB(B0, 1, 0); PG8_LDB(B1, 1, 1); PG8_SCHED; PG8_LDA(At, 1, 0); PG8_STAGE(PG8_SA(0, 1), a2, x1);
            PG8_WAIT_V(8); PG8_WAIT_L(0); PG8_BAR; PG8_MMA(0, 0, At, B0); PG8_MMA(0, 1, At, B1); PG8_BAR; PG8_SCHED;
            PG8_LDA(At, 1, 1); PG8_STAGE(PG8_SB(1, 0), b3, voffB); PG8_STAGE(PG8_SB(1, 1), b3 + hstep, voffB); PG8_STAGE(PG8_SA(1, 0), a3, x0);
            PG8_WAIT_V(8); PG8_WAIT_L(0); PG8_BAR; PG8_MMA(1, 0, At, B0); PG8_MMA(1, 1, At, B1); PG8_BAR; PG8_SCHED;
        }
        if (wr == 0) PG8_BAR;
        E(acc, cur, wr, wc, fr, fq);
        if (!has_next) break;
#pragma unroll
        for (int a = 0; a < 2; ++a)
#pragma unroll
            for (int b = 0; b < 2; ++b)
#pragma unroll
                for (int m = 0; m < 4; ++m)
#pragma unroll
                    for (int n = 0; n < 2; ++n) acc[a][b][m][n] = (f32x4){0.f, 0.f, 0.f, 0.f};
        cur = nxt; cB = nB; ++ui;
        cv0[0] = nv0[0]; cv0[1] = nv0[1]; cv1[0] = nv1[0]; cv1[1] = nv1[1];
        if (wr == 1) PG8_BAR;
    }
    PG8_WAIT_V(0);
    PG8_BAR;
#undef PG8_TOKS
#undef PG8_SA
#undef PG8_SB
#undef PG8_STAGE
#undef PG8_LDA
#undef PG8_LDB
#undef PG8_MMA
#undef PG8_WAIT_V
#undef PG8_WAIT_L
#undef PG8_BAR
#undef PG8_SCHED
}
}
#include <hip/hip_bf16.h>
#include <cmath>
namespace attn_body {
using bf16=__hip_bfloat16;
using bf16x8=__attribute__((ext_vector_type(8)))short;
using s16x4=__attribute__((ext_vector_type(4)))short;
using f32x16=__attribute__((ext_vector_type(16)))float;
using u32x4=__attribute__((ext_vector_type(4)))unsigned;
constexpr int BATCH=8,NHEAD=8,SEQ=2048,D=64,QP=512,KP=128;
constexpr int NW=8,QBLK=32,QB=QBLK*NW,KVBLK=64,NQB=SEQ/QB;
constexpr int ATTN_UNIT_ROWS=QB;
__device__ __forceinline__ int crow(int r,int hi){return (r&3)+8*(r>>2)+4*hi;}
#define SBAR() __builtin_amdgcn_sched_barrier(0)
__device__ __forceinline__ void cmask(f32x16&p0,f32x16&p1,int jb,int qrel,int hi){
  const float NEG=-INFINITY; int kb=64*jb+4*hi;
  #pragma unroll
  for(int r=0;r<16;++r){int kv=kb+(r&3)+8*(r>>2); if(kv>qrel)p0[r]=NEG; if(kv+32>qrel)p1[r]=NEG;}
}

constexpr int NSLOT=3, SLOTB=8192;
constexpr int LDS_K=0, LDS_V=NSLOT*SLOTB, LDS_WS=2*NSLOT*SLOTB, LDS_OST=LDS_WS+NW*64*4, LDS_BYTES=LDS_OST+NW*4096;
constexpr float C2=0.125f*1.4426950408889634f;
__device__ __forceinline__ void glds16(const void*gsrc,unsigned lds_dst){unsigned keep;
  asm volatile("s_mov_b32 %0, m0\n\ts_mov_b32 m0, %2\n\ts_nop 0\n\tglobal_load_lds_dwordx4 %1, off\n\ts_mov_b32 m0, %0":"=&s"(keep):"v"(gsrc),"s"(lds_dst):"memory");}
__device__ __forceinline__ float max3f(float a,float b,float c){float r;asm("v_max3_f32 %0, %1, %2, %3":"=v"(r):"v"(a),"v"(b),"v"(c));return r;}
__device__ __forceinline__ float max2f(float a,float b){float r;asm("v_max_f32_e32 %0, %1, %2":"=v"(r):"v"(a),"v"(b));return r;}
__device__ __forceinline__ float fadd_s(float a,float b){float r;asm("v_add_f32_e32 %0, %1, %2":"=v"(r):"v"(a),"v"(b));return r;}
__device__ __forceinline__ float fsub_s(float a,float b){float r;asm("v_sub_f32_e32 %0, %1, %2":"=v"(r):"v"(a),"v"(b));return r;}
typedef float f32x2_t __attribute__((ext_vector_type(2))); typedef __bf16 bf16x2_t __attribute__((ext_vector_type(2)));
__device__ __forceinline__ unsigned cvtpk_s(float lo,float hi){f32x2_t v={lo,hi};bf16x2_t b=__builtin_convertvector(v,bf16x2_t);return __builtin_bit_cast(unsigned,b);}
#define WAIT_BAR(N) asm volatile("s_waitcnt vmcnt(" #N ") lgkmcnt(0)\n\ts_barrier":::"memory")

__device__ __forceinline__ void qkt(f32x16&p0,f32x16&p1,const char*Kslot,const bf16x8*qr,const f32x16&negm,int r32,int hi){
  const char*kb=Kslot+hi*1024+r32*16;
  #pragma unroll
  for(int d0=0;d0<4;++d0){
    const bf16x8 b0=*reinterpret_cast<const bf16x8*>(kb+d0*2048);
    const bf16x8 b1=*reinterpret_cast<const bf16x8*>(kb+d0*2048+512);
    if(d0==0){p0=__builtin_amdgcn_mfma_f32_32x32x16_bf16(b0,qr[0],negm,0,0,0);p1=__builtin_amdgcn_mfma_f32_32x32x16_bf16(b1,qr[0],negm,0,0,0);}
    else{p0=__builtin_amdgcn_mfma_f32_32x32x16_bf16(b0,qr[d0],p0,0,0,0);p1=__builtin_amdgcn_mfma_f32_32x32x16_bf16(b1,qr[d0],p1,0,0,0);}}
}
typedef __attribute__((address_space(3))) const char* lds_cptr;
typedef short v4i16_t __attribute__((ext_vector_type(4)));
__device__ __forceinline__ void kload8(bf16x8*kf,lds_cptr kp){
  kf[0]=*(const __attribute__((address_space(3))) bf16x8*)(kp);      kf[1]=*(const __attribute__((address_space(3))) bf16x8*)(kp+512);
  kf[2]=*(const __attribute__((address_space(3))) bf16x8*)(kp+2048); kf[3]=*(const __attribute__((address_space(3))) bf16x8*)(kp+2560);
  kf[4]=*(const __attribute__((address_space(3))) bf16x8*)(kp+4096); kf[5]=*(const __attribute__((address_space(3))) bf16x8*)(kp+4608);
  kf[6]=*(const __attribute__((address_space(3))) bf16x8*)(kp+6144); kf[7]=*(const __attribute__((address_space(3))) bf16x8*)(kp+6656);
}
__device__ __forceinline__ void kload2(bf16x8*kf,lds_cptr kp,int j){ kf[2*j]=*(const __attribute__((address_space(3))) bf16x8*)(kp+j*2048); kf[2*j+1]=*(const __attribute__((address_space(3))) bf16x8*)(kp+j*2048+512); }
__device__ __forceinline__ s16x4 vtr(lds_cptr p){ return __builtin_bit_cast(s16x4,__builtin_amdgcn_ds_read_tr16_b64_v4i16((__attribute__((address_space(3))) v4i16_t*)p)); }
__device__ __forceinline__ float rowmax(const f32x16&p0,const f32x16&p1){
  float a=max3f(p0[0],p0[1],p1[0]),b=max3f(p0[2],p0[3],p1[1]);a=max3f(a,p1[2],p1[3]);
  #pragma unroll
  for(int r=4;r<16;r+=4){a=max3f(a,p0[r],p0[r+1]);b=max3f(b,p0[r+2],p0[r+3]);a=max3f(a,p1[r],p1[r+1]);b=max3f(b,p1[r+2],p1[r+3]);}
  const float m=max2f(a,b);
  auto rr=__builtin_amdgcn_permlane32_swap(__float_as_uint(m),__float_as_uint(m),false,false);
  return max2f(__uint_as_float(rr[0]),__uint_as_float(rr[1]));
}
__device__ __forceinline__ void pv(f32x16*o,int vb,bf16x8 pa0,bf16x8 pa1,bf16x8 pa2,bf16x8 pa3){
  #pragma unroll
  for(int d0=0;d0<2;++d0){s16x4 lo[4],hi[4];
    #pragma unroll
    for(int ks=0;ks<4;++ks){
      asm volatile("ds_read_b64_tr_b16 %0,%1 offset:%c2":"=&v"(lo[ks]):"v"(vb),"i"(d0*4096+ks*1024):"memory");
      asm volatile("ds_read_b64_tr_b16 %0,%1 offset:%c2":"=&v"(hi[ks]):"v"(vb),"i"(d0*4096+ks*1024+512):"memory");}
    asm volatile("s_waitcnt lgkmcnt(0)":::"memory");SBAR();
    #define PK(k) (bf16x8){lo[k][0],lo[k][1],lo[k][2],lo[k][3],hi[k][0],hi[k][1],hi[k][2],hi[k][3]}
    o[d0]=__builtin_amdgcn_mfma_f32_32x32x16_bf16(pa0,PK(0),o[d0],0,0,0);
    o[d0]=__builtin_amdgcn_mfma_f32_32x32x16_bf16(pa1,PK(1),o[d0],0,0,0);
    o[d0]=__builtin_amdgcn_mfma_f32_32x32x16_bf16(pa2,PK(2),o[d0],0,0,0);
    o[d0]=__builtin_amdgcn_mfma_f32_32x32x16_bf16(pa3,PK(3),o[d0],0,0,0);
    #undef PK
  }
}

#ifndef ATTN_STORE16
#define ATTN_STORE16(p,v) (*(u32x4*)(p)=(v))
#endif
__device__ __forceinline__ void attn_unit(int b,int h,int qb,const bf16*Q,const bf16*__restrict__ K,const bf16*__restrict__ V,bf16*O,char*shm,float M0){
  const int tid=threadIdx.x,lane=tid&63,r32=lane&31,hi=lane>>5; const int wid=__builtin_amdgcn_readfirstlane(tid>>6);
  const long rowbase=(long)b*SEQ; const int q0=qb*QB;
  const bf16*Qw=Q+(rowbase+q0+wid*QBLK)*QP+h*D;
  const bf16*Kh=K+rowbase*KP+(h>>2)*D,*Vh=V+rowbase*KP+(h>>2)*D;
  const unsigned lds0=(unsigned)(uintptr_t)shm;
  float*wsf=(float*)(shm+LDS_WS)+wid*64;
  const bf16*ksrc=Kh+(long)lane*KP+wid*8;
  const bf16*vsrc=Vh+(long)(16*(wid&3)+(lane>>2))*KP+(wid>>2)*32+(lane&3)*8;
  const unsigned kdst=lds0+LDS_K+wid*1024, vdst=lds0+LDS_V+wid*1024;
  #define DMA_K(t,slot) glds16(ksrc+(long)(t)*KVBLK*KP,(unsigned)__builtin_amdgcn_readfirstlane(kdst+(slot)))
  #define DMA_V(t,slot) glds16(vsrc+(long)(t)*KVBLK*KP,(unsigned)__builtin_amdgcn_readfirstlane(vdst+(slot)))
  const int vb0=(int)(lds0+LDS_V)+((lane>>4)&1)*32+(lane&3)*8+(4*hi+((lane&15)>>2))*64;
  const char*Kbase=shm+LDS_K; bf16x8 kf[8];
  const lds_cptr shm3=(lds_cptr)shm; const lds_cptr kp0=shm3+LDS_K+hi*1024+r32*16; const lds_cptr vp0=shm3+LDS_V+((lane>>4)&1)*32+(lane&3)*8+(4*hi+((lane&15)>>2))*64;
  constexpr int NT=SEQ/KVBLK;
  DMA_K(0,0);DMA_V(0,0);DMA_K(1,SLOTB);
  bf16x8 qr[4];
  #pragma unroll
  for(int d0=0;d0<4;++d0)qr[d0]=*reinterpret_cast<const bf16x8*>(&Qw[(long)r32*QP+d0*16+hi*8]);
  float l_reg=0.f;f32x16 o[2];o[0]=f32x16{};o[1]=f32x16{};f32x16 negm;
  #pragma unroll
  for(int r=0;r<16;++r)negm[r]=-M0;
  asm volatile("":"+v"(negm));
  #define CMASK(P0,P1,t) do{}while(0)
  #define START(P0,P1) do{ _Pragma("unroll") for(int r=0;r<16;++r)P0[r]=__builtin_amdgcn_exp2f(P0[r]); }while(0)
  #define RESC() do{}while(0)
  f32x16 pA0,pA1,pB0,pB1;
  int sl_prev=0,sl_cur=0,sl_next=SLOTB;
  #define ROT() do{sl_prev=sl_cur;sl_cur=sl_next;sl_next=(sl_next==(NSLOT-1)*SLOTB)?0:sl_next+SLOTB;}while(0)
  DMA_K(2,2*SLOTB);
  WAIT_BAR(3);
  qkt(pA0,pA1,Kbase,qr,negm,r32,hi);asm volatile("s_nop 15\n\ts_nop 7":"+v"(pA0),"+v"(pA1));CMASK(pA0,pA1,0);
  START(pA0,pA1);
  _Pragma("unroll") for(int r=0;r<16;++r)pA1[r]=__builtin_amdgcn_exp2f(pA1[r]);
  WAIT_BAR(0);
  DMA_K(3,0);DMA_V(1,SLOTB);
  ROT();
  kload8(kf,kp0+sl_cur);
  WAIT_BAR(2);
  s16x4 vlo[8],vhi[8]; u32x4 pw0,pw1,pw2,pw3;
  #define PKW(P,B) cvtpk_s(P[B],P[B+1])
  #define PAF(k) __builtin_bit_cast(bf16x8,pw##k)
  #define VFR(i) (bf16x8){vlo[i][0],vlo[i][1],vlo[i][2],vlo[i][3],vhi[i][0],vhi[i][1],vhi[i][2],vhi[i][3]}
  #define PIN(x) asm volatile("":"+v"(x))
  #define MX3(a,b,c) __builtin_fmaxf(__builtin_fmaxf((a),(b)),(c))
  #define GAPA(MF,A0,A1,A2,A3,W0,W1,PW) do{ MF; sacc+=A0; sacc+=A1; sacc+=A2; sacc+=A3; PIN(sacc); W0; W1; PIN(PW); SBAR(); }while(0)
  #define EX(v) __builtin_amdgcn_exp2f(v)
  #define GAPB(MF,X,B) do{ MF; X[B]=EX(X[B]); X[B+1]=EX(X[B+1]); X[B+2]=EX(X[B+2]); X[B+3]=EX(X[B+3]); PIN(X); SBAR(); }while(0)
  #define VRD(i) do{ vlo[i]=vtr(vp_+(((i)>>2)*4096+((i)&3)*1024)); vhi[i]=vtr(vp_+(((i)>>2)*4096+((i)&3)*1024+512)); }while(0)
  #define KRD(G,j) do{ if(G){ kload2(kf,kp0+sl_next,j); SBAR(); } }while(0)
  #define STEP(C0,C1,P0,P1,t,GK,GV,GL) do{ SBAR(); \
    const lds_cptr vp_=vp0+sl_prev; \
    VRD(0); SBAR(); float sacc=(P0[0]+P0[1]); \
    GAPA(C0=__builtin_amdgcn_mfma_f32_32x32x16_bf16(kf[0],qr[0],negm,0,0,0), P0[2],P0[3],P0[4],P0[5],     pw0[0]=PKW(P0,0), pw0[1]=PKW(P0,2), pw0); \
    VRD(4); SBAR(); GAPA(C1=__builtin_amdgcn_mfma_f32_32x32x16_bf16(kf[1],qr[0],negm,0,0,0), P0[6],P0[7],P0[8],P0[9],     pw0[2]=PKW(P0,4), pw0[3]=PKW(P0,6), pw0); \
    VRD(1); SBAR(); GAPA(C0=__builtin_amdgcn_mfma_f32_32x32x16_bf16(kf[2],qr[1],C0,0,0,0),   P0[10],P0[11],P0[12],P0[13], pw1[0]=PKW(P0,8), pw1[1]=PKW(P0,10), pw1); \
    VRD(5); SBAR(); GAPA(C1=__builtin_amdgcn_mfma_f32_32x32x16_bf16(kf[3],qr[1],C1,0,0,0),   P0[14],P0[15],P1[0],P1[1],   pw1[2]=PKW(P0,12),pw1[3]=PKW(P0,14), pw1); \
    VRD(2); SBAR(); GAPA(C0=__builtin_amdgcn_mfma_f32_32x32x16_bf16(kf[4],qr[2],C0,0,0,0),   P1[2],P1[3],P1[4],P1[5],     pw2[0]=PKW(P1,0), pw2[1]=PKW(P1,2), pw2); \
    VRD(6); SBAR(); GAPA(C1=__builtin_amdgcn_mfma_f32_32x32x16_bf16(kf[5],qr[2],C1,0,0,0),   P1[6],P1[7],P1[8],P1[9],     pw2[2]=PKW(P1,4), pw2[3]=PKW(P1,6), pw2); \
    VRD(3); SBAR(); GAPA(C0=__builtin_amdgcn_mfma_f32_32x32x16_bf16(kf[6],qr[3],C0,0,0,0),   P1[10],P1[11],P1[12],P1[13], pw3[0]=PKW(P1,8), pw3[1]=PKW(P1,10), pw3); \
    VRD(7); SBAR(); GAPA(C1=__builtin_amdgcn_mfma_f32_32x32x16_bf16(kf[7],qr[3],C1,0,0,0),   P1[14],P1[15],0.f,0.f,       pw3[2]=PKW(P1,12),pw3[3]=PKW(P1,14), pw3); \
    l_reg+=sacc; \
    if(GK){DMA_K((t)+3,sl_cur);} if(GV){DMA_V((t)+1,sl_next);} \
    CMASK(C0,C1,t); \
    SBAR(); \
    GAPB(o[0]=__builtin_amdgcn_mfma_f32_32x32x16_bf16(PAF(0),VFR(0),o[0],0,0,0), C0,0); \
    GAPB(o[1]=__builtin_amdgcn_mfma_f32_32x32x16_bf16(PAF(0),VFR(4),o[1],0,0,0), C0,4); \
    KRD(GL,0); GAPB(o[0]=__builtin_amdgcn_mfma_f32_32x32x16_bf16(PAF(1),VFR(1),o[0],0,0,0), C0,8); \
    KRD(GL,1); GAPB(o[1]=__builtin_amdgcn_mfma_f32_32x32x16_bf16(PAF(1),VFR(5),o[1],0,0,0), C0,12); \
    KRD(GL,2); GAPB(o[0]=__builtin_amdgcn_mfma_f32_32x32x16_bf16(PAF(2),VFR(2),o[0],0,0,0), C1,0); \
    KRD(GL,3); GAPB(o[1]=__builtin_amdgcn_mfma_f32_32x32x16_bf16(PAF(2),VFR(6),o[1],0,0,0), C1,4); \
    GAPB(o[0]=__builtin_amdgcn_mfma_f32_32x32x16_bf16(PAF(3),VFR(3),o[0],0,0,0), C1,8); \
    GAPB(o[1]=__builtin_amdgcn_mfma_f32_32x32x16_bf16(PAF(3),VFR(7),o[1],0,0,0), C1,12); \
    }while(0)
  int t=1;
  for(;t+5<NT;t+=2){
    STEP(pB0,pB1,pA0,pA1,t,true,true,true);     WAIT_BAR(2); RESC(); ROT();
    STEP(pA0,pA1,pB0,pB1,t+1,true,true,true);   WAIT_BAR(2); RESC(); ROT();
  }
  #define ENDW(tt) do{ if((tt)+3<NT){WAIT_BAR(2);} else if((tt)+2<NT){WAIT_BAR(1);} else {WAIT_BAR(0);} }while(0)
  for(;t+1<NT;t+=2){
    STEP(pB0,pB1,pA0,pA1,t,(t+3<NT),(t+1<NT),(t+1<NT));       ENDW(t);   RESC(); ROT();
    STEP(pA0,pA1,pB0,pB1,t+1,(t+4<NT),(t+2<NT),(t+2<NT));     ENDW(t+1); RESC(); ROT();
  }
  STEP(pB0,pB1,pA0,pA1,NT-1,false,false,false); RESC();
  { float sacc=pB0[0]+pB0[1]; _Pragma("unroll") for(int r=2;r<16;++r)sacc+=pB0[r]; _Pragma("unroll") for(int r=0;r<16;++r)sacc+=pB1[r]; l_reg+=sacc;
    pw0=(u32x4){PKW(pB0,0),PKW(pB0,2),PKW(pB0,4),PKW(pB0,6)};pw1=(u32x4){PKW(pB0,8),PKW(pB0,10),PKW(pB0,12),PKW(pB0,14)};pw2=(u32x4){PKW(pB1,0),PKW(pB1,2),PKW(pB1,4),PKW(pB1,6)};pw3=(u32x4){PKW(pB1,8),PKW(pB1,10),PKW(pB1,12),PKW(pB1,14)};
    SBAR(); pv(o,vb0+sl_cur,PAF(0),PAF(1),PAF(2),PAF(3)); }
  #undef PKW
  #undef PAF
  #undef VFR
  #undef PIN
  #undef MX3
  #undef GAPA
  #undef GAPB
  #undef EX
  #undef VRD
  #undef KRD
  #undef STEP
  #undef ENDW
  {auto rr=__builtin_amdgcn_permlane32_swap(__float_as_uint(l_reg),__float_as_uint(l_reg),false,false);l_reg=__uint_as_float(rr[0])+__uint_as_float(rr[1]);}
  if(hi==0)wsf[32+r32]=l_reg;asm volatile("s_waitcnt lgkmcnt(0)":::"memory");
  float rli[16];
  #pragma unroll
  for(int r=0;r<16;++r)rli[r]=__builtin_amdgcn_rcpf(wsf[32+crow(r,hi)]);
  bf16*Ow=O+(rowbase+q0+wid*QBLK)*QP+h*D;
  { bf16*stg=(bf16*)(shm+LDS_OST)+wid*2048;
    #pragma unroll
    for(int r=0;r<16;++r){const int orow=crow(r,hi);
      #pragma unroll
      for(int d0=0;d0<2;++d0)stg[orow*64+d0*32+r32]=__float2bfloat16(o[d0][r]*rli[r]);}
    asm volatile("s_waitcnt lgkmcnt(0)":::"memory");
    #pragma unroll
    for(int i=0;i<4;++i){const int row=i*8+(lane>>3),ch=lane&7; const u32x4 v=*(const u32x4*)(stg+row*64+ch*8); ATTN_STORE16(Ow+(long)row*QP+ch*8,v);} }
  asm volatile("s_waitcnt lgkmcnt(0)\n\ts_barrier":::"memory");
  #undef DMA_K
  #undef DMA_V
  #undef CMASK
  #undef START
  #undef RESC
  #undef ROT
}
constexpr int ATTN_LDS_BYTES=LDS_BYTES;
struct AttnTensors { const bf16* Q; const bf16* K; const bf16* V; bf16* O; };
struct AttnUnit { int bh; int qb; };
struct StaticOrder {
  int vcu,G;
  __device__ __forceinline__ explicit StaticOrder(int grid,int block):vcu((grid%8==0)?(block%8)*(grid/8)+block/8:block),G(grid){}
  __device__ __forceinline__ bool next(int i,AttnUnit&u)const{ const int L=vcu*2+i; if(i>=2&&G==256)return false; if(G==256){u.bh=(L>>6)*8+((L&63)>>3); u.qb=L&7; return true;}
    const int L2=i*G+vcu; if(L2>=BATCH*NHEAD*NQB)return false; u.bh=L2>>3; u.qb=L2&7; return true; }
};
template<class Sched> __device__ __forceinline__ void attn_phase(char*lds,const AttnTensors&T,const Sched&S,float M0){
  AttnUnit u;
  for(int i=0;S.next(i,u);++i){ attn_unit(u.bh/NHEAD,u.bh%NHEAD,u.qb,T.Q,T.K,T.V,T.O,lds,M0); }
}
#undef SBAR
#undef WAIT_BAR
}
#define XB_TMO      128
#define XB_XCNT(j)  (256  + 64 * (j))
#define XB_XSUB(j)  (1280 + 64 * (j))
#define XB_XGEN(j)  (2304 + 64 * (j))
#define XB_TOP      3328
#define XB_TOPGEN   3392
#define XCD_BAR_WORDS 3456
#define XB_SPIN_CAP (1u << 18)

__device__ __forceinline__ unsigned xb_ld(unsigned* p)              { return __hip_atomic_load(p, __ATOMIC_RELAXED, __HIP_MEMORY_SCOPE_AGENT); }
__device__ __forceinline__ unsigned xb_add(unsigned* p, unsigned v) { return __hip_atomic_fetch_add(p, v, __ATOMIC_RELAXED, __HIP_MEMORY_SCOPE_AGENT); }
__device__ __forceinline__ unsigned xb_xcc_id() { return (unsigned)__builtin_amdgcn_s_getreg((3 << 11) | 20) & 0xFu; }
#define XB_SPIN(cond, bar) do { unsigned _sp = 0; while (cond) { __builtin_amdgcn_s_sleep(1); \
    if ((++_sp & 255u) == 0u) { if (xb_ld(&(bar)[XB_TMO])) break; if (_sp > XB_SPIN_CAP) { atomicAdd(&(bar)[XB_TMO], 1u); break; } } } } while (0)

struct XcdBarrier {
    unsigned* bar; unsigned x;
    volatile LAS unsigned* st;
};

__device__ __forceinline__ XcdBarrier xcd_barrier_post(unsigned* bar, volatile LAS unsigned* st) {
    XcdBarrier b; b.bar = bar; b.x = xb_xcc_id(); b.st = st;
    if (threadIdx.x == 0) (void)xb_add(&bar[XB_XCNT(b.x)], 1u);
    return b;
}
__device__ __forceinline__ void xcd_barrier_complete(unsigned* bar, unsigned x, unsigned& nloc, unsigned& nx) {
    const unsigned G = gridDim.x * gridDim.y * gridDim.z;
    unsigned sum, cnt, mine, sp = 0u;
    for (;;) {
        sum = 0u; cnt = 0u; mine = 0u;
#pragma unroll
        for (unsigned j = 0; j < 16; ++j) { const unsigned c = xb_ld(&bar[XB_XCNT(j)]); sum += c; cnt += (c > 0u) ? 1u : 0u; mine = (j == x) ? c : mine; }
        if (sum == G) break;
        __builtin_amdgcn_s_sleep(1);
        if ((++sp & 255u) == 0u) { if (xb_ld(&bar[XB_TMO])) break; if (sp > XB_SPIN_CAP) { atomicAdd(&bar[XB_TMO], 1u); break; } }
    }
    nloc = mine > 0u ? mine : 1u; nx = cnt > 0u ? cnt : 1u;
}

__device__ __forceinline__ void xcd_barrier(const XcdBarrier& b) {
    asm volatile("s_waitcnt vmcnt(0)" ::: "memory");
    __syncthreads();
    if (threadIdx.x == 0) {
        unsigned* bar = b.bar;
        __builtin_amdgcn_s_waitcnt(0);
        unsigned nloc = b.st[0], nx = b.st[1];
        if (nloc == 0u) { xcd_barrier_complete(bar, b.x, nloc, nx); b.st[0] = nloc; b.st[1] = nx; }
        const unsigned old = xb_add(&bar[XB_XSUB(b.x)], 1u);
        const unsigned gen = old / nloc;
        if (old + 1u == (gen + 1u) * nloc) {
            __builtin_amdgcn_fence(__ATOMIC_RELEASE, "agent");
            asm volatile("s_waitcnt vmcnt(0)" ::: "memory");
            const unsigned og = xb_add(&bar[XB_TOP], 1u);
            const unsigned tg = og / nx;
            if (og + 1u == (tg + 1u) * nx) xb_add(&bar[XB_TOPGEN], 1u);
            else XB_SPIN(xb_ld(&bar[XB_TOPGEN]) == tg, bar);
            __builtin_amdgcn_fence(__ATOMIC_ACQUIRE, "agent");
            xb_add(&bar[XB_XGEN(b.x)], 1u);
            asm volatile("s_waitcnt vmcnt(0)" ::: "memory");
        } else {
            XB_SPIN(xb_ld(&bar[XB_XGEN(b.x)]) == gen, bar);
            __builtin_amdgcn_fence(__ATOMIC_ACQUIRE, "agent");
            asm volatile("s_waitcnt vmcnt(0)" ::: "memory");
        }
    }
    __syncthreads();
}
__device__ __forceinline__ void p_tables(const Ctx& C0) { const Ctx C = fresh(C0);
    unsigned char* ws = C.ws;
    const float *qn_a = inp(C, I_QNA), *kn_a = inp(C, I_KNA), *qn_b = inp(C, I_QNB), *kn_b = inp(C, I_KNB);
    f32x2v* ropeA = (f32x2v*)(ws + WS_TAB + TAB_ROPEA); f32x2v* rowt = (f32x2v*)(ws + WS_TAB + TAB_ROW); f32x2v* colt = (f32x2v*)(ws + WS_TAB + TAB_COL);
    for (int i = C.bid + C.G * C.tid; i < 2048 * 8 + 32 * 16 + 64 * 16; i += C.G * NTHR) {
        if (i < 2048 * 8) { const int pos = i >> 3, f = i & 7; const double a = (double)pos * pow(500000.0, -(double)f / 8.0); ropeA[i] = (f32x2v){(float)cos(a), (float)sin(a)}; }
        else if (i < 2048 * 8 + 512) { const int j = i - 2048 * 8, pos = j >> 4, f = j & 15; const double a = (double)pos * pow(10000.0, -(double)f / 16.0); rowt[j] = (f32x2v){(float)cos(a), (float)sin(a)}; }
        else { const int j = i - 2048 * 8 - 512, pos = j >> 4, f = j & 15; const double a = (double)pos * pow(10000.0, -(double)f / 16.0); colt[j] = (f32x2v){(float)cos(a), (float)sin(a)}; }
    }
    if (C.bid == C.G - 1 && C.tid == NTHR - 1) {
        float ma = 0.f;
        for (int g = 0; g < 3; ++g) { float q = 0.f, k = 0.f; for (int d = 0; d < 64; ++d) { q = fmaxf(q, fabsf(qn_a[g * 64 + d])); k = fmaxf(k, fabsf(kn_a[g * 64 + d])); } ma = fmaxf(ma, q * k); }
        float q = 0.f, k = 0.f; for (int d = 0; d < 64; ++d) { q = fmaxf(q, fabsf(qn_b[d])); k = fmaxf(k, fabsf(kn_b[d])); }
        float* sh = (float*)(ws + WS_TAB + TAB_SHIFT); sh[0] = 64.f * ma * C2 * 1.02f; sh[1] = 64.f * q * k * C2 * 1.02f;
    }
}

template <int MAP> __device__ __forceinline__ void transpose_item(const float* W, int N, int nblk, bf16* WT, int ldk, int row_off, LAS float* scr, int item, int lane) {
    const int kb = item / nblk, nb = item % nblk, k0 = 64 * kb, n0 = 32 * nb;
    if (MAP == 1 || true) {
        if (MAP == 1) {
            const int cm = colmap_in(n0 + (lane & 31));
#pragma unroll
            for (int i = 0; i < 32; ++i) { const int kk = 2 * i + (lane >> 5); scr[kk * 33 + (lane & 31)] = __builtin_nontemporal_load(W + (size_t)(k0 + kk) * N + cm); }
        } else {
            const int c0 = MAP == 2 ? colmap_gu(n0) : n0, n4 = (lane & 7) * 4; f32x4 v[8];
#pragma unroll
            for (int i = 0; i < 8; ++i) v[i] = __builtin_nontemporal_load((const f32x4*)(W + (size_t)(k0 + 8 * i + (lane >> 3)) * N + c0 + n4));
#pragma unroll
            for (int i = 0; i < 8; ++i) { LAS float* d = scr + (8 * i + (lane >> 3)) * 33 + n4; d[0] = v[i].x; d[1] = v[i].y; d[2] = v[i].z; d[3] = v[i].w; }
        }
    }
    asm volatile("s_waitcnt lgkmcnt(0)" ::: "memory");
    const int c = lane & 7;
#pragma unroll
    for (int j = 0; j < 4; ++j) { const int n = (lane >> 3) + 8 * j; const LAS float* s = scr + (8 * c) * 33 + n;
        u32x4 o; o.x = pk2(s[0 * 33], s[1 * 33]); o.y = pk2(s[2 * 33], s[3 * 33]); o.z = pk2(s[4 * 33], s[5 * 33]); o.w = pk2(s[6 * 33], s[7 * 33]);
        *(u32x4*)(WT + (size_t)(row_off + n0 + n) * ldk + k0 + 8 * c) = o; }
    asm volatile("s_waitcnt lgkmcnt(0)" ::: "memory");
}
__device__ __forceinline__ void rms_row_to_bf16(const float* xrow, const float* g, bf16* orow, int lane) {
    const f32x4* xr = (const f32x4*)xrow + lane; const f32x4* gr = (const f32x4*)g + lane;
    f32x4 v[4]; float s = 0.f;
#pragma unroll
    for (int j = 0; j < 4; ++j) { v[j] = __builtin_nontemporal_load(xr + 64 * j); s += (v[j].x * v[j].x + v[j].y * v[j].y) + (v[j].z * v[j].z + v[j].w * v[j].w); }
    const float rstd = 1.f / sqrtf(wave_sum(s) * (1.f / 1024.f) + EPS);
    unsigned long long* o8 = (unsigned long long*)orow + lane;
#pragma unroll
    for (int j = 0; j < 4; ++j) { const f32x4 gg = gr[64 * j]; o8[64 * j] = (unsigned long long)pk2(v[j].x * rstd * gg.x, v[j].y * rstd * gg.y) | ((unsigned long long)pk2(v[j].z * rstd * gg.z, v[j].w * rstd * gg.w) << 32); }
}
__device__ __forceinline__ void p_prep(const Ctx& C0) { const Ctx C = fresh(C0);
    LAS float* scr = (LAS float*)(C.lds + C.wave * 16384);
    const int gw = C.bid * NWAVES + C.wave, NGW = C.G * NWAVES, lane = C.lane; unsigned char* ws = C.ws;
    constexpr int I_IN = 16 * (NIN / 32), I_PA = 8 * 32, I_OUT = 16 * 32, I_R = 16;
    constexpr int NITEMS = I_R + I_IN + 2 * I_PA + I_OUT;
    for (int it = gw; it < NITEMS; it += NGW) {
        int r = it;
        if (r < I_R) { transpose_item<0>(inp(C, I_WR), 32, 1, (bf16*)(ws + WS_WRT), 1024, 0, scr, r, lane); continue; } r -= I_R;
        if (r < I_IN) { transpose_item<1>(inp(C, I_WIN), NIN, NIN / 32, (bf16*)(ws + WS_WIN), 1024, 0, scr, r, lane); continue; } r -= I_IN;
        if (r < I_PA) { transpose_item<0>(inp(C, I_WPA), 1024, 32, (bf16*)(ws + WS_WPA), 512, 0, scr, r, lane); continue; } r -= I_PA;
        if (r < I_PA) { transpose_item<0>(inp(C, I_WPB), 1024, 32, (bf16*)(ws + WS_WPB), 512, 0, scr, r, lane); continue; } r -= I_PA;
        transpose_item<0>(inp(C, I_WOUT), 1024, 32, (bf16*)(ws + WS_WOUT), 1024, 0, scr, r, lane);
    }
    for (int m = gw; m < TOK; m += NGW) rms_row_to_bf16(inp(C, I_X) + (size_t)m * DM, inp(C, I_GMIX), (bf16*)(ws + WS_XN) + (size_t)m * DM, lane);
}
constexpr int QN_GU = NEXP * 16 * 64, QN_D = NEXP * 16 * 32;
template <int WHICH> __device__ __forceinline__ void cq_load(f32x4 (&v)[8], const float* Wb, int it, int lane) {
    constexpr int N = WHICH == 0 ? 2048 : 1024, NB = N / 32, IPE = 16 * NB;
    const int e = it / IPE, r = it % IPE, kb = r / NB, nb = r % NB, k0 = 64 * kb, n0 = 32 * nb, c0 = WHICH == 0 ? colmap_gu(n0) : n0;
    const float* W = Wb + (size_t)e * 1024 * N + (size_t)(k0 + (lane >> 3)) * N + c0 + (lane & 7) * 4;
#pragma unroll
    for (int i = 0; i < 8; ++i) v[i] = __builtin_nontemporal_load((const f32x4*)(W + (size_t)(8 * i) * N));
}
template <int WHICH, bool NTST = true> __device__ __forceinline__ void cq_finish(const f32x4 (&v)[8], bf16* WTb, int it, LAS float* scr, int lane) {
    constexpr int N = WHICH == 0 ? 2048 : 1024, NB = N / 32, IPE = 16 * NB;
    const int e = it / IPE, r = it % IPE, kb = r / NB, nb = r % NB, k0 = 64 * kb, n0 = 32 * nb;
#pragma unroll
    for (int i = 0; i < 8; ++i) { LAS float* d = scr + (8 * i + (lane >> 3)) * 33 + (lane & 7) * 4; d[0] = v[i].x; d[1] = v[i].y; d[2] = v[i].z; d[3] = v[i].w; }
    asm volatile("s_waitcnt lgkmcnt(0)" ::: "memory");
    const int c = lane & 7;
#pragma unroll
    for (int j = 0; j < 4; ++j) { const int n = (lane >> 3) + 8 * j; const LAS float* s = scr + (8 * c) * 33 + n;
        u32x4 o; o.x = pk2(s[0 * 33], s[1 * 33]); o.y = pk2(s[2 * 33], s[3 * 33]); o.z = pk2(s[4 * 33], s[5 * 33]); o.w = pk2(s[6 * 33], s[7 * 33]);
        u32x4* dst = (u32x4*)(WTb + (size_t)(e * N + n0 + n) * 1024 + k0 + 8 * c); if constexpr (NTST) __builtin_nontemporal_store(o, dst); else *dst = o; }
    asm volatile("s_waitcnt lgkmcnt(0)" ::: "memory");
}
template <int WHICH, bool NTST = true> __device__ __forceinline__ void p_convq(const Ctx& C0, unsigned* stop_word, unsigned stop_at) { const Ctx C = fresh(C0);
    LAS float* scr = (LAS float*)(C.lds + C.wave * 16384); unsigned char* ws = C.ws; const int lane = C.lane;
    constexpr int QN = WHICH == 0 ? QN_GU : QN_D, SH = QN / 8, CH = 4;
    const int shard = C.bid & 7;
    unsigned* q = (unsigned*)(ws + WS_CTL) + (WHICH == 0 ? CW_QGU : CW_QD) + 64 * shard;
    const float* W = inp(C, WHICH == 0 ? I_WGU : I_WD); bf16* WT = (bf16*)(ws + (WHICH == 0 ? WS_WGU : WS_WD));
    for (;;) {
        unsigned it0 = 0, dn = 0;
        if (lane == 0) { it0 = atomicAdd(q, (unsigned)CH); if (stop_word) dn = __hip_atomic_load(stop_word, RLX_AGENT); }
        it0 = (unsigned)__builtin_amdgcn_readfirstlane((int)it0); dn = (unsigned)__builtin_amdgcn_readfirstlane((int)dn);
        if (it0 >= (unsigned)SH) break;
        const int base = shard * SH + (int)it0;
        f32x4 va[8], vb[8];
        cq_load<WHICH>(va, W, base, lane);
#pragma unroll
        for (int c = 0; c < CH; c += 2) {
            cq_load<WHICH>(vb, W, base + c + 1, lane); cq_finish<WHICH, NTST>(va, WT, base + c, scr, lane);
            if (c + 2 < CH) cq_load<WHICH>(va, W, base + c + 2, lane);
            cq_finish<WHICH, NTST>(vb, WT, base + c + 1, scr, lane); }
        if (stop_word && dn >= stop_at) break;
    }
}
__device__ __forceinline__ void p_router2(const Ctx& C0) { const Ctx C = fresh(C0);
    typedef short bf16x8 __attribute__((ext_vector_type(8))); typedef float f32x16 __attribute__((ext_vector_type(16)));
    unsigned char* ws = C.ws; const int tid = C.tid, lane = C.lane, wave = C.wave, r32 = lane & 31, hi = lane >> 5;
    const float* g = inp(C, I_GFFN); const float* b_r = inp(C, I_BR); const bf16* WRT = (const bf16*)(ws + WS_WRT);
    constexpr int RSB = 2064;
    LAS unsigned char* RH = C.lds; LAS float* PART = (LAS float*)(C.lds + 32 * RSB); LAS int* CN = (LAS int*)(C.lds + 32 * RSB + 8 * 32 * 33 * 4);
    const int rqs = C.bid & 7; unsigned* rq = (unsigned*)(ws + WS_CTL) + CW_RQ + 64 * rqs;
    for (;;) {
        if (tid == 0) CN[64] = (int)atomicAdd(rq, 1u);
        if (tid < 32) CN[tid] = 0;
        __syncthreads();
        const int bl = CN[64]; if (bl >= TOK / 32 / 8) break;
        const int blk = rqs * (TOK / 32 / 8) + bl;
        const int row0 = blk * 32;
#pragma unroll
        for (int q = 0; q < 4; ++q) { const int rl = wave * 4 + q, row = row0 + rl;
            const bf16* xr = (const bf16*)(ws + WS_X1) + (size_t)row * DM + 8 * lane;
            float v[2][8]; float s = 0.f;
#pragma unroll
            for (int hh = 0; hh < 2; ++hh) { const u32x4 w = *(const u32x4*)(xr + 512 * hh);
                v[hh][0] = __uint_as_float(w.x << 16); v[hh][1] = __uint_as_float(w.x & 0xffff0000u); v[hh][2] = __uint_as_float(w.y << 16); v[hh][3] = __uint_as_float(w.y & 0xffff0000u);
                v[hh][4] = __uint_as_float(w.z << 16); v[hh][5] = __uint_as_float(w.z & 0xffff0000u); v[hh][6] = __uint_as_float(w.w << 16); v[hh][7] = __uint_as_float(w.w & 0xffff0000u);
#pragma unroll
                for (int i = 0; i < 8; ++i) s += v[hh][i] * v[hh][i]; }
            const float rstd = 1.f / sqrtf(wave_sum(s) * (1.f / 1024.f) + EPS);
            bf16* o8 = (bf16*)(ws + WS_H2) + (size_t)row * DM + 8 * lane;
#pragma unroll
            for (int hh = 0; hh < 2; ++hh) { const f32x4 g0 = *(const f32x4*)(g + 512 * hh + 8 * lane), g1 = *(const f32x4*)(g + 512 * hh + 8 * lane + 4);
                u32x4 w; w.x = pk2(v[hh][0] * rstd * g0.x, v[hh][1] * rstd * g0.y); w.y = pk2(v[hh][2] * rstd * g0.z, v[hh][3] * rstd * g0.w); w.z = pk2(v[hh][4] * rstd * g1.x, v[hh][5] * rstd * g1.y); w.w = pk2(v[hh][6] * rstd * g1.z, v[hh][7] * rstd * g1.w);
                *(u32x4*)(o8 + 512 * hh) = w; *(LAS u32x4*)(RH + rl * RSB + (512 * hh + 8 * lane) * 2) = w; } }
        __syncthreads();
        { f32x16 acc = {};
#pragma unroll
          for (int s = 0; s < 8; ++s) { const int k0 = 128 * wave + 16 * s + 8 * hi;
              const bf16x8 a = *(const bf16x8*)(WRT + (size_t)r32 * 1024 + k0); const bf16x8 b = *(const LAS bf16x8*)(RH + r32 * RSB + k0 * 2);
              acc = __builtin_amdgcn_mfma_f32_32x32x16_bf16(a, b, acc, 0, 0, 0); }
#pragma unroll
          for (int i = 0; i < 16; ++i) PART[(wave * 32 + r32) * 33 + (i & 3) + 8 * (i >> 2) + 4 * hi] = acc[i]; }
        __syncthreads();
        int my_e = 0, my_pos = 0; float my_g = 0.f; const int rr = tid >> 3, sub = tid & 7;
        if (tid < 256) {
            unsigned key[4];
#pragma unroll
            for (int c = 0; c < 4; ++c) { const int e = sub * 4 + c; float a = b_r[e];
#pragma unroll
                for (int w = 0; w < 8; ++w) a += PART[(w * 32 + rr) * 33 + e];
                const unsigned u = __float_as_uint(a); key[c] = (((u & 0x80000000u) ? ~u : (u | 0x80000000u)) & ~31u) | (unsigned)(31 - e); }
            unsigned top[4];
#pragma unroll
            for (int k = 0; k < 4; ++k) { unsigned m = key[0] > key[1] ? key[0] : key[1]; const unsigned m2 = key[2] > key[3] ? key[2] : key[3]; m = m > m2 ? m : m2;
#pragma unroll
                for (int o = 1; o < 8; o <<= 1) { const unsigned x = (unsigned)__shfl_xor((int)m, o); m = m > x ? m : x; }
                top[k] = m;
#pragma unroll
                for (int c = 0; c < 4; ++c) if (key[c] == m) key[c] = 0u; }
            float tv[4];
#pragma unroll
            for (int k = 0; k < 4; ++k) { const unsigned kk = top[k] & ~31u; tv[k] = __uint_as_float((kk & 0x80000000u) ? (kk & 0x7fffffffu) : ~kk); }
            const float e1 = __expf(tv[1] - tv[0]), e2 = __expf(tv[2] - tv[0]), e3 = __expf(tv[3] - tv[0]); const float rs = 1.f / (1.f + e1 + e2 + e3);
            if (sub < 4) { const unsigned t = sub == 0 ? top[0] : sub == 1 ? top[1] : sub == 2 ? top[2] : top[3]; my_e = 31 - (int)(t & 31u);
                my_g = (sub == 0 ? 1.f : sub == 1 ? e1 : sub == 2 ? e2 : e3) * rs;
                my_pos = __hip_atomic_fetch_add(CN + my_e, 1, __ATOMIC_RELAXED, __HIP_MEMORY_SCOPE_WORKGROUP); }
        }
        __syncthreads();
        if (tid < 32) { const int c = CN[tid]; CN[32 + tid] = c ? (int)atomicAdd((unsigned*)(ws + WS_CTL) + CW_CNT + tid, (unsigned)c) : 0; }
        __syncthreads();
        if (tid < 256 && sub < 4) { const int row = row0 + rr, slot = CN[32 + my_e] + my_pos;
            int* list = (int*)(ws + WS_LIST) + ((size_t)my_e * LISTCAP + slot) * 2; list[0] = row; list[1] = __float_as_int(my_g);
            int* pair = (int*)(ws + WS_PAIR) + ((size_t)row * 4 + sub) * 2; pair[0] = my_e; pair[1] = slot; }
        __syncthreads();
    }
}
__device__ __forceinline__ void p_meta2(const Ctx& C0) { const Ctx C = fresh(C0);
    LAS int* meta = (LAS int*)(C.lds + META_OFF); LAS int* tokTab = (LAS int*)(C.lds + TOKTAB_OFF);
    if (C.tid < 64) {
        const int cnt = C.tid < NEXP ? (int)__hip_atomic_load((unsigned*)(C.ws + WS_CTL) + CW_CNT + (C.tid & 31), RLX_AGENT) : 0; const int nt = (cnt + 255) >> 8; int inc = nt;
#pragma unroll
        for (int o = 1; o < 32; o <<= 1) { const int v = __shfl_up(inc, o); if ((C.tid & 63) >= o) inc += v; }
        if (C.tid < NEXP) { meta[MT_CNT + C.tid] = cnt; meta[MT_BASE + C.tid] = inc - nt; }
        if (C.tid == NEXP - 1) { meta[MT_BASE + NEXP] = inc; meta[MT_NT] = inc; } }
    __syncthreads();
    if (C.tid < MAXTILES) { int e = 0; for (int q = 1; q < NEXP; ++q) if (meta[MT_BASE + q] <= C.tid) e = q; meta[MT_TILE + C.tid] = e; }
    __syncthreads();
    const int nunits = meta[MT_NT] * 8, G7 = gemm_grid(nunits, C.G); const int* list = (const int*)(C.ws + WS_LIST);
    if (C.bid < G7) for (int x = C.tid; x < MAXUNITS_GU * 256; x += NTHR) { const int i = x >> 8, r = x & 255; const long L = (long)i * G7 + xcd_rank(C.bid, G7); int tok = 0;
        if (L < nunits) { const int t = (int)(L >> 3), e = meta[MT_TILE + t], slot = 256 * (t - meta[MT_BASE + e]) + r; if (slot < meta[MT_CNT + e]) tok = list[((size_t)e * LISTCAP + slot) * 2]; }
        tokTab[x] = tok; }
    __syncthreads();
}
__device__ __forceinline__ void p_combine(const Ctx& C0) { const Ctx C = fresh(C0);
    unsigned char* ws = C.ws; const LAS int* meta = (const LAS int*)(C.lds + META_OFF); const int lane = C.lane;
    const bf16* Y = (const bf16*)(ws + WS_Y); const int step = C.G * NWAVES * 2;
    const int row2 = (pg8::moe_split_full(meta[MT_NT] * 4, C.G) >> 2) << 8; const bf16* Y2 = (const bf16*)(ws + WS_Y2) - (size_t)row2 * DM;
    int t0 = (C.bid * NWAVES + C.wave) * 2;
    u32x4 pc[4], pn[4];
    if (t0 < TOK) { const u32x4* pp = (const u32x4*)((const int*)(ws + WS_PAIR) + (size_t)t0 * 8);
#pragma unroll
        for (int q = 0; q < 4; ++q) pc[q] = pp[q]; }
    for (; t0 < TOK; t0 += step) {
        u32x4 a[2][2]; u32x4 y[2][4][2], y2[2][4][2];
#pragma unroll
        for (int r = 0; r < 2; ++r) { const int t = t0 + r;
            const bf16* xp = (const bf16*)(ws + WS_X1) + (size_t)t * DM + 8 * lane;
            a[r][0] = __builtin_nontemporal_load((const u32x4*)xp); a[r][1] = __builtin_nontemporal_load((const u32x4*)(xp + 512));
#pragma unroll
            for (int k = 0; k < 4; ++k) { const u32x4 w = pc[2 * r + (k >> 1)]; const int e = __builtin_amdgcn_readfirstlane((int)((k & 1) ? w.z : w.x)), slot = __builtin_amdgcn_readfirstlane((int)((k & 1) ? w.w : w.y));
                const size_t row = (size_t)256 * meta[MT_BASE + e] + slot;
                const bf16* yp = Y + row * DM + 8 * lane; y[r][k][0] = __builtin_nontemporal_load((const u32x4*)yp); y[r][k][1] = __builtin_nontemporal_load((const u32x4*)(yp + 512));
                y2[r][k][0] = y2[r][k][1] = (u32x4){0u, 0u, 0u, 0u};
                if (row >= (size_t)row2) { const bf16* zp = Y2 + row * DM + 8 * lane; y2[r][k][0] = __builtin_nontemporal_load((const u32x4*)zp); y2[r][k][1] = __builtin_nontemporal_load((const u32x4*)(zp + 512)); } } }
        if (t0 + step < TOK) { const u32x4* pp = (const u32x4*)((const int*)(ws + WS_PAIR) + (size_t)(t0 + step) * 8);
#pragma unroll
            for (int q = 0; q < 4; ++q) pn[q] = pp[q]; }
#pragma unroll
        for (int r = 0; r < 2; ++r) { float* op = C.out + (size_t)(t0 + r) * DM + 8 * lane;
#pragma unroll
            for (int h = 0; h < 2; ++h) { const u32x4 xw = a[r][h]; f32x4 lo = {__uint_as_float(xw.x << 16), __uint_as_float(xw.x & 0xffff0000u), __uint_as_float(xw.y << 16), __uint_as_float(xw.y & 0xffff0000u)}, hi = {__uint_as_float(xw.z << 16), __uint_as_float(xw.z & 0xffff0000u), __uint_as_float(xw.w << 16), __uint_as_float(xw.w & 0xffff0000u)};
#pragma unroll
                for (int k = 0; k < 4; ++k) { const u32x4 w = y[r][k][h], w2 = y2[r][k][h];
                    lo.x += __uint_as_float(w2.x << 16); lo.y += __uint_as_float(w2.x & 0xffff0000u); lo.z += __uint_as_float(w2.y << 16); lo.w += __uint_as_float(w2.y & 0xffff0000u);
                    hi.x += __uint_as_float(w2.z << 16); hi.y += __uint_as_float(w2.z & 0xffff0000u); hi.z += __uint_as_float(w2.w << 16); hi.w += __uint_as_float(w2.w & 0xffff0000u);
                    lo.x += __uint_as_float(w.x << 16); lo.y += __uint_as_float(w.x & 0xffff0000u); lo.z += __uint_as_float(w.y << 16); lo.w += __uint_as_float(w.y & 0xffff0000u);
                    hi.x += __uint_as_float(w.z << 16); hi.y += __uint_as_float(w.z & 0xffff0000u); hi.z += __uint_as_float(w.w << 16); hi.w += __uint_as_float(w.w & 0xffff0000u); }
                __builtin_nontemporal_store(lo, (f32x4*)(op + h * 512)); __builtin_nontemporal_store(hi, (f32x4*)(op + h * 512 + 4)); } }
#pragma unroll
        for (int q = 0; q < 4; ++q) pc[q] = pn[q];
    }
}
namespace attn_a {
typedef short bf16x8 __attribute__((ext_vector_type(8)));
typedef short s16x4 __attribute__((ext_vector_type(4)));
typedef float f32x16 __attribute__((ext_vector_type(16)));
typedef float f32x2_t __attribute__((ext_vector_type(2))); typedef __bf16 bf16x2_t __attribute__((ext_vector_type(2)));
constexpr int RS = 160, RSK = 144;
constexpr int A_IMG = 0, A_ROW = 132, A_VST = 512 * A_ROW, A_WST = 32 * (RS + RSK), A_KOFF = 32 * RS, A_BYTES = A_VST + 8 * A_WST;
static_assert(A_BYTES <= LDSCTL_OFF, "mixer A LDS");
__device__ __forceinline__ unsigned cvtpk(float lo, float hi) { f32x2_t v = {lo, hi}; bf16x2_t b = __builtin_convertvector(v, bf16x2_t); return __builtin_bit_cast(unsigned, b); }
__device__ __forceinline__ s16x4 vtr(const LAS unsigned char* p) { typedef short v4i16_t __attribute__((ext_vector_type(4))); return __builtin_bit_cast(s16x4, __builtin_amdgcn_ds_read_tr16_b64_v4i16((LAS v4i16_t*)p)); }
__device__ __forceinline__ int crow(int r, int hi) { return (r & 3) + 8 * (r >> 2) + 4 * hi; }

struct ItemP { int g, dil, L, m0, r, nq, pmul, padd, hh; };
__device__ __forceinline__ ItemP item_params(int it, int span, int h) { ItemP P; P.nq = 32;
    if (it < 16) { P.g = 0; P.dil = 1; P.L = 2048; P.m0 = 512 * span + 32 * it; P.r = 0; P.pmul = 1; P.padd = 32 * it; }
    else if (it < 32) { const int x = it - 16; P.g = 1; P.dil = 4; P.L = 512; P.r = x >> 2; P.m0 = 128 * span + 32 * (x & 3); P.pmul = 4; P.padd = 128 * (x & 3) + P.r; }
    else { P.g = 2; P.dil = 16; P.L = 128; P.r = it - 32; P.m0 = 32 * span; P.pmul = 16; P.padd = P.r; }
    P.hh = h; return P; }
__device__ __forceinline__ long slab_row(const ItemP& P, int tokbase, int m) { return ((long)((tokbase >> 11) * 24 + P.g * 8 + P.hh) * 2048 + P.r * P.L + m) * 64; }
template <bool DOK, bool DOV> __device__ __forceinline__ void load_tile(const ItemP& P, int k, int tokbase, const bf16* KA, const bf16* VA, int lane, u32x4 (&kfn)[4], u32x4 (&vrn)[4]) {
    const int mk0 = P.m0 - 64 + 32 * k;
    if (mk0 < 0 || mk0 >= P.L) {
#pragma unroll
        for (int c = 0; c < 4; ++c) { if (DOK) kfn[c] = (u32x4){0u, 0u, 0u, 0u}; if (DOV) vrn[c] = (u32x4){0u, 0u, 0u, 0u}; }
        return; }
    const long sb = slab_row(P, tokbase, mk0) * 2;
    const unsigned voff = (unsigned)lane * 16u;
#pragma unroll
    for (int c = 0; c < 4; ++c) { const long so = sb + 1024 * c;
        if (DOK) kfn[c] = *(const u32x4*)((const char*)KA + so + voff); if (DOV) vrn[c] = *(const u32x4*)((const char*)VA + so + voff); }
}
__device__ __forceinline__ void preload(const ItemP& P, int tokbase, const bf16* QA, const bf16* KA, const bf16* VA, int lane, bf16x8 (&qf)[4], u32x4 (&kfn)[4]) {
    u32x4 vrn[4];
    const int r32 = lane & 31, hi = lane >> 5, qi = r32;
    const bf16* qp = QA + slab_row(P, tokbase, P.m0 + qi) + hi * 8;
#pragma unroll
    for (int d0 = 0; d0 < 4; ++d0) qf[d0] = *(const bf16x8*)(qp + d0 * 16);
    load_tile<true, false>(P, 0, tokbase, KA, VA, lane, kfn, vrn);
}
template <bool G2> __device__ __forceinline__ void item(const Ctx& C, int ii, int b, int h, int span, int tokbase, float M0, const bf16* QA, const bf16* KA, const bf16* VA, LAS unsigned char* IMG, LAS unsigned char* vst, int wr_off, int tr_off, bf16x8 (&qf)[4], u32x4 (&kfn)[4]) {
    int lane_ = C.lane; asm volatile("" : "+v"(lane_));
    const int lane = lane_, wave = C.wave, r32 = lane & 31, hi = lane >> 5;

            const ItemP P = item_params(ii * 8 + wave, span, h);
            const int dil = P.dil, L = P.L, m0 = P.m0, r = P.r, pmul = P.pmul, padd = P.padd; (void)dil; (void)r;
            u32x4 kb[2][4], vb[2][4];
#pragma unroll
            for (int d0 = 0; d0 < 4; ++d0) kb[0][d0] = kfn[d0];
            load_tile<false, true>(P, 0, tokbase, KA, VA, lane, kfn, vb[0]);
            load_tile<true, true>(P, 1, tokbase, KA, VA, lane, kb[1], vb[1]);
            f32x16 o0 = {}, o1 = {}; float l = 0.f;
            const LAS unsigned char* tb = vst + tr_off;
#define A_IN(k) ((m0 - 64 + 32 * (k)) >= 0 && (m0 - 64 + 32 * (k)) < L)
#define A_STAGE_K(buf) do { _Pragma("unroll") for (int c = 0; c < 4; ++c) *(LAS u32x4*)(vst + A_KOFF + (8 * c + (lane >> 3)) * RSK + (lane & 7) * 16) = kb[buf][c]; } while (0)
#define A_STAGE_V(buf) do { _Pragma("unroll") for (int c = 0; c < 4; ++c) *(LAS u32x4*)(vst + (8 * c + (lane >> 3)) * RS + (lane & 7) * 16) = vb[buf][c]; } while (0)
#define A_READ_K() do { _Pragma("unroll") for (int d0 = 0; d0 < 4; ++d0) kf[d0] = *(const LAS bf16x8*)(vst + A_KOFF + r32 * RSK + 32 * d0 + 16 * hi); } while (0)
#define A_QK(dst, init) do { _Pragma("unroll") for (int i = 0; i < 16; ++i) dst[i] = (init); _Pragma("unroll") for (int d0 = 0; d0 < 4; ++d0) dst = __builtin_amdgcn_mfma_f32_32x32x16_bf16(kf[d0], qf[d0], dst, 0, 0, 0); } while (0)
#define A_VF(dblk, s) ({ const s16x4 lo_ = vtr(tb + (16 * (s)) * RS + (dblk) * 64), hi_ = vtr(tb + (16 * (s) + 8) * RS + (dblk) * 64); (bf16x8){lo_[0], lo_[1], lo_[2], lo_[3], hi_[0], hi_[1], hi_[2], hi_[3]}; })
            bf16x8 kf[4]; f32x16 sc[2];
            A_STAGE_K(0); A_READ_K(); A_QK(sc[0], A_IN(0) ? -M0 : -1e30f); A_STAGE_V(0);
#pragma unroll
            for (int k = 0; k < 5; ++k) {
                if (k < 3) load_tile<true, true>(P, k + 2, tokbase, KA, VA, lane, kb[k & 1], vb[k & 1]);
                if (k < 4) { A_STAGE_K((k + 1) & 1); A_READ_K(); }
                bf16x8 pa0, pa1;
                { f32x16& acc = sc[k & 1]; float p[16]; float ls = 0.f;
#pragma unroll
                    for (int i = 0; i < 16; ++i) { const int kr = crow(i, hi); bool valid = true;
                        if (k == 0) valid = kr >= r32;
                        if (k == 4) valid = kr <= r32;
                        const float ex = __builtin_amdgcn_exp2f(acc[i]);
                        p[i] = (k == 0 || k == 4) ? (valid ? ex : 0.f) : ex; ls += p[i]; }
                    l += ls;
                    u32x4 pw0, pw1;
                    pw0.x = cvtpk(p[0], p[1]); pw0.y = cvtpk(p[2], p[3]); pw0.z = cvtpk(p[4], p[5]); pw0.w = cvtpk(p[6], p[7]);
                    pw1.x = cvtpk(p[8], p[9]); pw1.y = cvtpk(p[10], p[11]); pw1.z = cvtpk(p[12], p[13]); pw1.w = cvtpk(p[14], p[15]);
                    pa0 = __builtin_bit_cast(bf16x8, pw0); pa1 = __builtin_bit_cast(bf16x8, pw1); }
                const bf16x8 v00 = A_VF(0, 0), v01 = A_VF(0, 1), v10 = A_VF(1, 0), v11 = A_VF(1, 1);
                if (k < 4) A_QK(sc[(k + 1) & 1], A_IN(k + 1) ? -M0 : -1e30f);
                o0 = __builtin_amdgcn_mfma_f32_32x32x16_bf16(v00, pa0, o0, 0, 0, 0); o0 = __builtin_amdgcn_mfma_f32_32x32x16_bf16(v01, pa1, o0, 0, 0, 0);
                o1 = __builtin_amdgcn_mfma_f32_32x32x16_bf16(v10, pa0, o1, 0, 0, 0); o1 = __builtin_amdgcn_mfma_f32_32x32x16_bf16(v11, pa1, o1, 0, 0, 0);
                if (k < 4) A_STAGE_V((k + 1) & 1);
            }
#undef A_IN
#undef A_STAGE_K
#undef A_STAGE_V
#undef A_READ_K
#undef A_QK
#undef A_VF
            if (ii < 5) { const ItemP PN = item_params((ii + 1) * 8 + wave, span, h); preload(PN, tokbase, QA, KA, VA, lane, qf, kfn); }
            l += __shfl_xor(l, 32);
            { LAS unsigned char* rowp = IMG + (r32 * pmul + padd) * A_ROW + 8 * hi;
              if (ii < 2) {
#pragma unroll
                for (int gq = 0; gq < 4; ++gq) { LAS unsigned* d0 = (LAS unsigned*)(rowp + 16 * gq); LAS unsigned* d1 = (LAS unsigned*)(rowp + 64 + 16 * gq);
                    d0[0] = cvtpk(o0[4 * gq], o0[4 * gq + 1]); d0[1] = cvtpk(o0[4 * gq + 2], o0[4 * gq + 3]); d1[0] = cvtpk(o1[4 * gq], o1[4 * gq + 1]); d1[1] = cvtpk(o1[4 * gq + 2], o1[4 * gq + 3]); }
                if (hi == 0) *(LAS float*)(rowp + 128) = l;
              } else {
#pragma unroll
                for (int gq = 0; gq < 4; ++gq) { LAS unsigned* d0 = (LAS unsigned*)(rowp + 16 * gq); LAS unsigned* d1 = (LAS unsigned*)(rowp + 64 + 16 * gq);
                    const unsigned a0 = d0[0], a1 = d0[1], b0 = d1[0], b1 = d1[1];
                    d0[0] = cvtpk(o0[4 * gq] + __uint_as_float(a0 << 16), o0[4 * gq + 1] + __uint_as_float(a0 & 0xffff0000u)); d0[1] = cvtpk(o0[4 * gq + 2] + __uint_as_float(a1 << 16), o0[4 * gq + 3] + __uint_as_float(a1 & 0xffff0000u));
                    d1[0] = cvtpk(o1[4 * gq] + __uint_as_float(b0 << 16), o1[4 * gq + 1] + __uint_as_float(b0 & 0xffff0000u)); d1[1] = cvtpk(o1[4 * gq + 2] + __uint_as_float(b1 << 16), o1[4 * gq + 3] + __uint_as_float(b1 & 0xffff0000u)); }
                if (hi == 0) *(LAS float*)(rowp + 128) += l;
              } }
        }
__device__ __forceinline__ void phase(const Ctx& C0) { const Ctx C = fresh(C0);
    unsigned char* ws = C.ws; const int tid = C.tid, lane = C.lane, wave = C.wave, hi = lane >> 5;
    const bf16* QA = (const bf16*)(ws + WS_QA); const bf16* KA = (const bf16*)(ws + WS_KA); const bf16* VA = (const bf16*)(ws + WS_VA);
    const float M0 = ((const float*)(ws + WS_TAB + TAB_SHIFT))[0];
    LAS unsigned char* IMG = C.lds + A_IMG; LAS unsigned char* vst = C.lds + A_VST + wave * A_WST;
    const int vcu = (C.G % 8 == 0) ? (C.bid % 8) * (C.G / 8) + C.bid / 8 : C.bid, nper = (256 + C.G - 1) / C.G;
    const int wr_off = 0;
    const int tr_off = (4 * hi + ((lane & 15) >> 2)) * RS + (((lane >> 4) & 1) * 16 + (lane & 3) * 4) * 2;
    for (int ui = 0; ui < nper; ++ui) {
        const int U = vcu * nper + ui; if (U >= 256) break;
        const int b = U >> 5, h = (U >> 2) & 7, span = U & 3, tokbase = b * SEQ;
        bf16x8 qf[4]; u32x4 kfn[4];
        { const ItemP P0 = item_params(wave, span, h); preload(P0, tokbase, QA, KA, VA, lane, qf, kfn); }
#pragma unroll 1
        for (int ii = 0; ii < 6; ++ii) {
            item<false>(C, ii, b, h, span, tokbase, M0, QA, KA, VA, IMG, vst, wr_off, tr_off, qf, kfn);
            if (ii == 1 || ii == 3) __syncthreads();
        }
        __syncthreads();
        bf16* OA = (bf16*)(ws + WS_OA) + (size_t)(tokbase + 512 * span) * 512 + h * 64;
        int tidn = tid; asm volatile("" : "+v"(tidn));
#pragma unroll
        for (int k = 0; k < 8; ++k) { const int item = tidn + NTHR * k, pos = item >> 3, ch = item & 7; const LAS unsigned* src = (const LAS unsigned*)(IMG + pos * A_ROW + 16 * ch); const float rl = 1.f / *(const LAS float*)(IMG + pos * A_ROW + 128);
            const unsigned s0 = src[0], s1 = src[1], s2 = src[2], s3 = src[3];
            u32x4 w; w.x = cvtpk(__uint_as_float(s0 << 16) * rl, __uint_as_float(s0 & 0xffff0000u) * rl); w.y = cvtpk(__uint_as_float(s1 << 16) * rl, __uint_as_float(s1 & 0xffff0000u) * rl);
            w.z = cvtpk(__uint_as_float(s2 << 16) * rl, __uint_as_float(s2 & 0xffff0000u) * rl); w.w = cvtpk(__uint_as_float(s3 << 16) * rl, __uint_as_float(s3 & 0xffff0000u) * rl);
            *(u32x4*)(OA + (size_t)pos * 512 + 8 * ch) = w; }
        __syncthreads();
    }
}
}
struct Args { const float* in[18]; float* out; unsigned char* ws; };
__global__ void __launch_bounds__(NTHR, 2) fwd(Args args) {
    extern __shared__ __attribute__((aligned(16))) unsigned char lds_raw[];
    Ctx C;
    C.out = args.out; C.ws = args.ws; C.lds = (LAS unsigned char*)lds_raw;
    C.tid = threadIdx.x; C.lane = C.tid & 63; C.wave = __builtin_amdgcn_readfirstlane(C.tid >> 6); C.G = gridDim.x; C.bid = blockIdx.x;
    unsigned char* ws = C.ws;
    for (int u = C.tid; u < (LDS_BYTES - LDSCTL_OFF) / 4; u += NTHR) ((LAS unsigned*)(C.lds + LDSCTL_OFF))[u] = 0u;
    __syncthreads();
    if (C.tid < 18) ((LAS unsigned long long*)(C.lds + PTR_OFF))[C.tid] = (unsigned long long)args.in[C.tid];
    __syncthreads();
    volatile LAS unsigned* MISC = (volatile LAS unsigned*)(C.lds + MISC_OFF);
    XcdBarrier bar = xcd_barrier_post((unsigned*)(ws + WS_CTL) + CW_BAR, MISC + 8);
    typedef pg8::bf16_t b16;
    PG8_LAS unsigned char* ring = (PG8_LAS unsigned char*)lds_raw;

    p_tables(C); p_prep(C);
    xcd_barrier(bar);
    { const int G1 = gemm_grid((TOK / 256) * (NIN / 256), C.G); unsigned* done1 = (unsigned*)(ws + WS_CTL) + CW_DONE1;
      if (C.bid < G1) { pg8::Gemm g{(const b16*)(ws + WS_XN), (const b16*)(ws + WS_WIN), TOK, NIN, DM, 0}; pg8::StaticOrder S; S.init(TOK, NIN, G1, C.bid);
          pg8::EpiInProj E{C.lds, ws}; pg8::gemm_phase<pg8::EpiInProj, pg8::StaticOrder, true, true>(ring, g, S, E);
          if (C.tid == 0) __hip_atomic_fetch_add(done1, 1u, RLX_AGENT); }
      else p_convq<0>(C, done1, (unsigned)G1); }
    xcd_barrier(bar);
    attn_a::phase(C);
    { const attn_body::AttnTensors AT{(const attn_body::bf16*)(ws + WS_QB), (const attn_body::bf16*)(ws + WS_KB), (const attn_body::bf16*)(ws + WS_VB), (attn_body::bf16*)(ws + WS_OB)};
      const attn_body::StaticOrder S((int)C.G, (int)C.bid); const float M0B = ((const float*)(ws + WS_TAB + TAB_SHIFT))[1];
      attn_body::attn_phase<attn_body::StaticOrder>((char*)lds_raw, AT, S, M0B); }
    xcd_barrier(bar);
    { pg8::Gemm g{(const b16*)(ws + WS_OA), (const b16*)(ws + WS_WPA), TOK, DM, 512, 0}; pg8::StaticOrder S; S.init(TOK, DM, C.G, C.bid);
      pg8::EpiGate<0> E{(const b16*)(ws + WS_GATES), (b16*)(ws + WS_TMP), (b16*)(ws + WS_MRG)}; pg8::gemm_phase<pg8::EpiGate<0>, pg8::StaticOrder, true, true>(ring, g, S, E); }
    { pg8::Gemm g{(const b16*)(ws + WS_OB), (const b16*)(ws + WS_WPB), TOK, DM, 512, 0}; pg8::StaticOrder S; S.init(TOK, DM, C.G, C.bid);
      pg8::EpiGate<1> E{(const b16*)(ws + WS_GATES), (b16*)(ws + WS_TMP), (b16*)(ws + WS_MRG)}; pg8::gemm_phase<pg8::EpiGate<1>, pg8::StaticOrder, true, true>(ring, g, S, E); }
    xcd_barrier(bar);
    { pg8::Gemm g{(const b16*)(ws + WS_MRG), (const b16*)(ws + WS_WOUT), TOK, DM, DM, 0}; pg8::StaticOrder S; S.init(TOK, DM, C.G, C.bid);
      pg8::EpiRes E{inp(C, I_X), (b16*)(ws + WS_X1), DM, 0}; pg8::gemm_phase<pg8::EpiRes, pg8::StaticOrder, true, true>(ring, g, S, E); }
    xcd_barrier(bar);
    if ((C.bid >> 3) & 1) { p_convq<0, false>(C, nullptr, 0u); __syncthreads(); p_router2(C); } else { p_router2(C); __syncthreads(); p_convq<0, false>(C, nullptr, 0u); }
    xcd_barrier(bar);
    p_meta2(C);
    const PG8_LAS int* meta = (const PG8_LAS int*)(C.lds + META_OFF);
    { const int G7 = gemm_grid(meta[MT_NT] * 8, C.G); unsigned* done7 = (unsigned*)(ws + WS_CTL) + CW_DONE7;
      if (C.bid < G7) { pg8::Gemm g{(const b16*)(ws + WS_H2), (const b16*)(ws + WS_WGU), TOK, NEXP * 2048, DM, 0}; pg8::MoeOrder S{meta + MT_TILE, meta[MT_NT], 8, G7, xcd_rank(C.bid, G7)};
          pg8::EpiSwiglu E{inp(C, I_BGU), (b16*)(ws + WS_ACT)}; pg8::gemm_phase_gather<pg8::EpiSwiglu, pg8::MoeOrder>(ring, g, S, E, (const PG8_LAS int*)(C.lds + TOKTAB_OFF));
          if (C.tid == 0) __hip_atomic_fetch_add(done7, 1u, RLX_AGENT);
          p_convq<1, false>(C, nullptr, 0u); }
      else { p_convq<1>(C, done7, (unsigned)G7); p_convq<1, false>(C, nullptr, 0u); } }
    xcd_barrier(bar);
    { pg8::Gemm g{(const b16*)(ws + WS_ACT), (const b16*)(ws + WS_WD), MAXTILES * 256, NEXP * 1024, DFF, ACT_PAD}; pg8::MoeSplitOrder S{meta + MT_TILE, meta[MT_NT], 4, C.G, xcd_rank(C.bid, C.G)};
      pg8::EpiDown E{inp(C, I_BD), (const int*)(ws + WS_LIST), meta, (b16*)(ws + WS_Y), (b16*)(ws + WS_Y2), (pg8::moe_split_full(meta[MT_NT] * 4, C.G) >> 2) << 8}; pg8::gemm_phase<pg8::EpiDown, pg8::MoeSplitOrder, true, true, true>(ring, g, S, E); }
    xcd_barrier(bar);
    p_combine(C);
}

extern "C" void kernel_launch(void* const* d_in, const int* in_sizes, int n_in, void* d_out, int out_size, void* d_ws, size_t ws_size, hipStream_t stream) {
    static int grid = 0;
    if (grid == 0) {
        if (n_in != 18 || in_sizes[0] != TOK * DM || out_size != TOK * DM || ws_size < WS_END) { fprintf(stderr, "kernel_launch: unexpected shapes (n_in %d in0 %d out %d ws %zu)\n", n_in, n_in > 0 ? in_sizes[0] : -1, out_size, ws_size); grid = -1; return; }
        int dev = 0, cus = 0, per_cu = 0;
        if (hipGetDevice(&dev) != hipSuccess || hipDeviceGetAttribute(&cus, hipDeviceAttributeMultiprocessorCount, dev) != hipSuccess) { fprintf(stderr, "kernel_launch: device query failed\n"); grid = -1; return; }
        if (hipFuncSetAttribute((const void*)fwd, hipFuncAttributeMaxDynamicSharedMemorySize, LDS_BYTES) != hipSuccess) { fprintf(stderr, "kernel_launch: hipFuncSetAttribute failed\n"); grid = -1; return; }
        if (hipOccupancyMaxActiveBlocksPerMultiprocessor(&per_cu, (const void*)fwd, NTHR, LDS_BYTES) != hipSuccess || per_cu < 1) fprintf(stderr, "kernel_launch: note: occupancy query reports %d workgroups per CU\n", per_cu);
        (void)hipGetLastError();
        grid = cus;
    }
    if (grid < 0) return;
    if (hipMemsetAsync((char*)d_ws + WS_CTL, 0, CTL_ZERO_BYTES, stream) != hipSuccess) { fprintf(stderr, "kernel_launch: memset failed\n"); return; }
    Args a; memset(&a, 0, sizeof(a));
    for (int i = 0; i < 18; ++i) a.in[i] = (const float*)d_in[i];
    a.out = (float*)d_out; a.ws = (unsigned char*)d_ws;
    hipLaunchKernelGGL(fwd, dim3(grid), dim3(NTHR), LDS_BYTES, stream, a);
    const hipError_t le = hipPeekAtLastError();
    if (le != hipSuccess) fprintf(stderr, "kernel_launch: launch failed: %s\n", hipGetErrorName(le));
}
```

```cpp
#include <hip/hip_runtime.h>
#include <cstdio>
#include <cstdint>
#include <cstring>
constexpr int BATCH = 8, SEQ = 2048, DM = 1024, TOK = BATCH * SEQ;
constexpr int NIN = 7424;
constexpr int NEXP = 32, DFF = 1024, TOPK = 4;
constexpr int MAXTILES = TOK * TOPK / 256 + NEXP;
constexpr int LISTCAP = TOK;
constexpr float EPS = 1e-6f;
constexpr float C2 = 0.125f * 1.4426950408889634f;

typedef unsigned short bf16;
typedef float f32x4 __attribute__((ext_vector_type(4)));
typedef unsigned u32x4 __attribute__((ext_vector_type(4)));
typedef unsigned u32x2 __attribute__((ext_vector_type(2)));
typedef float f32x2v __attribute__((ext_vector_type(2)));
#define LAS __attribute__((address_space(3)))

__device__ __forceinline__ unsigned f2bf(float f) { unsigned u = __builtin_bit_cast(unsigned, f); return (u + 0x7fffu + ((u >> 16) & 1u)) >> 16; }
typedef float f32x2k __attribute__((ext_vector_type(2))); typedef __bf16 bf16x2k __attribute__((ext_vector_type(2)));
constexpr float S_H = 16.f, S_W = 64.f, S_A = 4.f, S_Y = 16.f, S_M = 16.f, S_O = 16.f;
__device__ __forceinline__ unsigned pk4_fp8(float a, float b, float c, float d) { int w = __builtin_amdgcn_cvt_pk_fp8_f32(a, b, 0, false); w = __builtin_amdgcn_cvt_pk_fp8_f32(c, d, w, true); return (unsigned)w; }
typedef float f32x2y __attribute__((ext_vector_type(2)));
__device__ __forceinline__ f32x4 add4_fp8(f32x4 acc, unsigned w) { const f32x2y lo = __builtin_amdgcn_cvt_pk_f32_fp8((int)w, false), hi = __builtin_amdgcn_cvt_pk_f32_fp8((int)w, true); acc.x += lo.x; acc.y += lo.y; acc.z += hi.x; acc.w += hi.y; return acc; }
__device__ __forceinline__ unsigned pk2(float lo, float hi) { f32x2k v = {lo, hi}; bf16x2k b = __builtin_convertvector(v, bf16x2k); return __builtin_bit_cast(unsigned, b); }
__device__ __forceinline__ float bf2f(bf16 h) { return __uint_as_float((unsigned)h << 16); }
__device__ __forceinline__ float wave_sum(float v) {
#pragma unroll
    for (int o = 1; o < 64; o <<= 1) v += __shfl_xor(v, o);
    return v;
}

__host__ __device__ __forceinline__ int physA(int e) { if (e >= 32) return e; const int fq = e >> 3, n = (e >> 2) & 1, j = e & 3; return j < 2 ? 8 * n + 2 * fq + j : 16 + 4 * fq + 2 * n + (j - 2); }
__host__ __device__ __forceinline__ int physB(int e) { const int b = e & 32, fq = (e >> 3) & 3, n = (e >> 2) & 1, j = e & 3; return b + 16 * n + 4 * fq + j; }
__host__ __device__ __forceinline__ int colmap_in(int np) {
    const int pn = np >> 8, p = np & 255, hw = (p >> 5) & 3, e = ((p >> 7) << 5) | (p & 31);
    if (pn < 6)  return (pn >> 1) * 512 + (4 * (pn & 1) + hw) * 64 + physA(e);
    if (pn < 12) return 1536 + ((pn - 6) >> 1) * 512 + (4 * ((pn - 6) & 1) + hw) * 64 + physA(e);
    if (pn < 18) return 3072 + (pn - 12) * 256 + p;
    if (pn < 20) return 4608 + (4 * (pn - 18) + hw) * 64 + physB(e);
    if (pn == 20) return hw < 2 ? 5120 + hw * 64 + physB(e) : 5248 + (hw - 2) * 64 + e;
    return 5376 + (pn - 21) * 256 + p;
}
__host__ __device__ __forceinline__ int colmap_gu(int np) { const int pn = np >> 8, p = np & 255; return p < 128 ? pn * 128 + p : 1024 + pn * 128 + (p - 128); }

constexpr size_t MiB = 1u << 20;
constexpr size_t WS_CTL = 0;
constexpr size_t CTL_ZERO_BYTES = 1 * MiB;
constexpr size_t WS_TAB = 1 * MiB;
constexpr size_t WS_LIST = 2 * MiB;
constexpr size_t WS_PAIR = 6 * MiB;
constexpr size_t WS_WIN = 8 * MiB;
constexpr size_t WS_WPA = 23 * MiB;
constexpr size_t WS_WPB = 24 * MiB;
constexpr size_t WS_WOUT = 25 * MiB;
constexpr size_t WS_WRT = 27 * MiB;
constexpr size_t WS_WGU = 28 * MiB;
constexpr size_t WS_WD = 156 * MiB;
constexpr size_t WS_XN = 220 * MiB;
constexpr size_t WS_QA = 252 * MiB;
constexpr size_t WS_KA = 300 * MiB;
constexpr size_t WS_VA = 348 * MiB;
constexpr size_t WS_QB = 396 * MiB;
constexpr size_t WS_KB = 412 * MiB;
constexpr size_t WS_VB = 416 * MiB;
constexpr size_t WS_GATES = 420 * MiB;
constexpr size_t WS_OA = 484 * MiB;
constexpr size_t WS_OB = 500 * MiB;
constexpr size_t WS_TMP = 516 * MiB;
constexpr size_t WS_X1 = 516 * MiB;
constexpr size_t WS_MRG = 548 * MiB;
constexpr size_t WS_H2 = 580 * MiB;
constexpr size_t WS_ACT = 756 * MiB;
constexpr size_t WS_Y = 252 * MiB;
constexpr size_t WS_Y2 = 420 * MiB;
constexpr size_t WS_END = 900 * MiB;
constexpr int CW_CNT = 64;
constexpr size_t TAB_ROPEA = 0;
constexpr size_t TAB_ROW = 128 * 1024;
constexpr size_t TAB_COL = 132 * 1024;
constexpr size_t TAB_SHIFT = 140 * 1024;
constexpr size_t TAB_META = 141 * 1024;

constexpr int NTHR = 512, NWAVES = 8;
constexpr int RING_BYTES = 131072, LDSCTL_OFF = 147456, MISC_OFF = LDSCTL_OFF + 320, META_OFF = LDSCTL_OFF + 1024, LDS_BYTES = 163840;
constexpr int CW_BAR = 4096;
constexpr int CW_QGU = 256, CW_QD = 768, CW_DONE1 = 1280, CW_DONE7 = 1344, CW_RQ = 1536;
__host__ __device__ __forceinline__ int gemm_grid(int units, int G) { const int R = (units + G - 1) / G; int g = R > 0 ? (units + R - 1) / R : G; g = (g + 7) & ~7; return g > G ? G : (g < 8 ? 8 : g); }
constexpr int MT_NT = 0, MT_BASE = 1, MT_CNT = 34, MT_TILE = 96;
constexpr int TOKTAB_OFF = LDSCTL_OFF + 4096, MAXUNITS_GU = (MAXTILES * 8 + 255) / 256 + 1;
static_assert(TOKTAB_OFF + MAXUNITS_GU * 1024 <= LDS_BYTES, "LDS map");
#define RLX_AGENT __ATOMIC_RELAXED, __HIP_MEMORY_SCOPE_AGENT

constexpr int PTR_OFF = LDSCTL_OFF + 512;
__host__ __device__ __forceinline__ int xcd_rank(int b, int G) { return (G % 8 == 0) ? (b % 8) * (G / 8) + b / 8 : b; }
struct Ctx { float* out; unsigned char* ws; LAS unsigned char* lds; int tid, lane, wave, G, bid; };
__device__ __forceinline__ Ctx fresh(const Ctx& C) { Ctx L = C; int t = threadIdx.x; asm volatile("" : "+v"(t)); L.tid = t; L.lane = t & 63; L.wave = __builtin_amdgcn_readfirstlane(t >> 6); return L; }
__device__ __forceinline__ const float* ldptr(const LAS unsigned char* lds, int i) {
    const LAS unsigned* p = (const LAS unsigned*)(lds + PTR_OFF) + 2 * i;
    const unsigned lo = __builtin_amdgcn_readfirstlane(p[0]), hi = __builtin_amdgcn_readfirstlane(p[1]);
    return (const float*)(const __attribute__((address_space(1))) float*)(((unsigned long long)hi << 32) | lo);
}
__device__ __forceinline__ const float* inp(const Ctx& C, int i) {
    const LAS unsigned* p = (const LAS unsigned*)(C.lds + PTR_OFF) + 2 * i;
    const unsigned lo = __builtin_amdgcn_readfirstlane(p[0]), hi = __builtin_amdgcn_readfirstlane(p[1]);
    return (const float*)(const __attribute__((address_space(1))) float*)(((unsigned long long)hi << 32) | lo);
}
enum { I_X = 0, I_GMIX, I_WIN, I_BGATE, I_QNA, I_KNA, I_QNB, I_KNB, I_WPA, I_WPB, I_WOUT, I_GFFN, I_WR, I_BR, I_WGU, I_BGU, I_WD, I_BD };

namespace pg8 {
#define PG8_LAS __attribute__((address_space(3)))
typedef unsigned short bf16_t;
typedef short bf16x8 __attribute__((ext_vector_type(8)));
typedef float f32x4 __attribute__((ext_vector_type(4)));
typedef unsigned u32x4 __attribute__((ext_vector_type(4)));
constexpr int BM = 256, BK = 64, HALF = 128, HTB = HALF * BK * 2  , STAGE_BYTES = 8 * HTB, NXCD = 8, WGM = 8;

__host__ __device__ __forceinline__ int lds_byte(int r, int c) { const int st = (r >> 4) * 2 + (c >> 5), rr = r & 15, cc = c & 31, ob = rr * 64 + cc * 2; return st * 1024 + (ob ^ (((ob >> 9) & 1) << 5)); }
__host__ __device__ __forceinline__ void stage_rc(int b, int& R, int& C) { const int st = b / 1024, sb = b % 1024, swz = sb ^ (((sb >> 9) & 1) << 5); R = (st >> 1) * 16 + swz / 64; C = (st & 1) * 32 + (swz % 64) / 2; }
__host__ __device__ __forceinline__ int perm32(int rho) { const int n = rho >> 4, i = rho & 15; return 8 * (i >> 2) + 4 * n + (i & 3); }

struct Unit { int pm, pn, kh; };
struct Gemm { const bf16_t* A; const bf16_t* Bt; int M, N, K, pad; };

struct StaticOrder {
    int nM, nN, nwg, G, c;
    __host__ __device__ void init(int M, int N, int G_, int c_) { nM = M / BM; nN = N / BM; nwg = nM * nN; G = G_; c = c_; }
    __host__ __device__ bool next(int i, Unit& u) const {
        const long L = (long)i * G + c; if (L >= nwg) return false;
        int wgid = (int)L; { const int q = nwg / NXCD, r = nwg % NXCD, xcd = wgid % NXCD, off = wgid / NXCD; wgid = (xcd < r ? xcd * (q + 1) : r * (q + 1) + (xcd - r) * q) + off; }
        const int nig = WGM * nN, gid = wgid / nig, fm = gid * WGM, gsz = (nM - fm) < WGM ? (nM - fm) : WGM;
        u.pm = fm + ((wgid % nig) % gsz); u.pn = (wgid % nig) / gsz; return true;
    }
    __device__ __forceinline__ void a_ready(const Unit&) const {}
    __device__ __forceinline__ void done(const Unit&) const {}
};

typedef float f32x2c __attribute__((ext_vector_type(2))); typedef __bf16 bf16x2c __attribute__((ext_vector_type(2)));
__device__ __forceinline__ unsigned cvt_pk_bf16(float lo, float hi) { f32x2c v = {lo, hi}; bf16x2c b = __builtin_convertvector(v, bf16x2c); return __builtin_bit_cast(unsigned, b); }
typedef float f32x2 __attribute__((ext_vector_type(2)));
__device__ __forceinline__ void unpack8(const u32x4 w, float (&f)[8]) {
    f[0] = __uint_as_float(w.x << 16); f[1] = __uint_as_float(w.x & 0xffff0000u); f[2] = __uint_as_float(w.y << 16); f[3] = __uint_as_float(w.y & 0xffff0000u);
    f[4] = __uint_as_float(w.z << 16); f[5] = __uint_as_float(w.z & 0xffff0000u); f[6] = __uint_as_float(w.w << 16); f[7] = __uint_as_float(w.w & 0xffff0000u);
}
__device__ __forceinline__ u32x4 pack8(const float (&f)[8]) { u32x4 w; w.x = cvt_pk_bf16(f[0], f[1]); w.y = cvt_pk_bf16(f[2], f[3]); w.z = cvt_pk_bf16(f[4], f[5]); w.w = cvt_pk_bf16(f[6], f[7]); return w; }

struct EpiStore {
    static constexpr bool PERM = true, AFTER_DRAIN = false;
    bf16_t* O; int ldc, pad;
    __device__ __forceinline__ void operator()(const f32x4 (&acc)[2][2][4][2], const Unit& u, int wr, int wc, int fr, int fq) const {
        const int row0 = u.pm * BM + wr * 64 + fr, col0 = u.pn * BM + wc * 32 + 8 * fq;
#pragma unroll
        for (int ai = 0; ai < 2; ++ai)
#pragma unroll
            for (int m = 0; m < 4; ++m) { bf16_t* rowp = O + (size_t)(row0 + ai * HALF + m * 16) * ldc + col0;
#pragma unroll
                for (int bj = 0; bj < 2; ++bj) { const f32x4 v0 = acc[ai][bj][m][0], v1 = acc[ai][bj][m][1];
                    u32x4 w; w.x = cvt_pk_bf16(v0[0], v0[1]); w.y = cvt_pk_bf16(v0[2], v0[3]); w.z = cvt_pk_bf16(v1[0], v1[1]); w.w = cvt_pk_bf16(v1[2], v1[3]);
                    *(u32x4*)(rowp + bj * HALF) = w; } }
    }
};
template <int MODE> struct EpiGate {
    static constexpr bool PERM = true, AFTER_DRAIN = false;
    const bf16_t* G; bf16_t* TMP; bf16_t* OUT;
    __device__ __forceinline__ void operator()(const f32x4 (&acc)[2][2][4][2], const Unit& u, int wr, int wc, int fr, int fq) const {
        typedef unsigned u32x2g __attribute__((ext_vector_type(2)));
        const int row0 = u.pm * BM + wr * 64 + fr, col0 = u.pn * BM + wc * 32 + 8 * fq;
#pragma unroll
        for (int ai = 0; ai < 2; ++ai) { u32x2g gw[4][2]; u32x4 tw[4][2];
#pragma unroll
            for (int m = 0; m < 4; ++m) { const size_t row = (size_t)(row0 + ai * HALF + m * 16);
#pragma unroll
                for (int bj = 0; bj < 2; ++bj) { const int col = col0 + bj * HALF; gw[m][bj] = __builtin_nontemporal_load((const u32x2g*)((const unsigned char*)G + row * 2048 + MODE * 1024 + col));
                    if (MODE == 1) tw[m][bj] = *(const u32x4*)(TMP + row * 1024 + col); } }
            asm volatile("" ::: "memory");
#pragma unroll
            for (int m = 0; m < 4; ++m) { const size_t row = (size_t)(row0 + ai * HALF + m * 16);
#pragma unroll
                for (int bj = 0; bj < 2; ++bj) { const int col = col0 + bj * HALF; const f32x4 v0 = acc[ai][bj][m][0], v1 = acc[ai][bj][m][1]; float g[8], o[8];
#pragma unroll
                    for (int i = 0; i < 4; ++i) { g[i] = (float)((gw[m][bj].x >> (8 * i)) & 255u) * (1.0f / 255.0f); g[4 + i] = (float)((gw[m][bj].y >> (8 * i)) & 255u) * (1.0f / 255.0f); }
                    constexpr float co = 1.0f / (S_O * S_W); const float v[8] = {v0[0] * co, v0[1] * co, v0[2] * co, v0[3] * co, v1[0] * co, v1[1] * co, v1[2] * co, v1[3] * co};
                    if (MODE == 0) {
#pragma unroll
                        for (int i = 0; i < 8; ++i) o[i] = g[i] * v[i];
                        *(u32x4*)(TMP + row * 1024 + col) = pack8(o);
                    } else { float t[8]; unpack8(tw[m][bj], t);
#pragma unroll
                        for (int i = 0; i < 8; ++i) o[i] = t[i] + g[i] * v[i];
                        { typedef unsigned u32x2m __attribute__((ext_vector_type(2))); const u32x2m w8 = {pk4_fp8(o[0] * S_M, o[1] * S_M, o[2] * S_M, o[3] * S_M), pk4_fp8(o[4] * S_M, o[5] * S_M, o[6] * S_M, o[7] * S_M)};
                          *(u32x2m*)((unsigned char*)OUT + row * 1024 + col) = w8; } } } }
            asm volatile("" ::: "memory"); }
    }
};
struct EpiRes {
    static constexpr bool PERM = true, AFTER_DRAIN = false;
    const float* base; bf16_t* out; int ldc, pad;
    __device__ __forceinline__ void operator()(const f32x4 (&acc)[2][2][4][2], const Unit& u, int wr, int wc, int fr, int fq) const {
        const int row0 = u.pm * BM + wr * 64 + fr, col0 = u.pn * BM + wc * 32 + 8 * fq;
#pragma unroll
        for (int ai = 0; ai < 2; ++ai) { f32x4 xb[4][2][2];
#pragma unroll
            for (int m = 0; m < 4; ++m) { const size_t off = (size_t)(row0 + ai * HALF + m * 16) * ldc + col0;
#pragma unroll
                for (int bj = 0; bj < 2; ++bj) { xb[m][bj][0] = __builtin_nontemporal_load((const f32x4*)(base + off + bj * HALF)); xb[m][bj][1] = __builtin_nontemporal_load((const f32x4*)(base + off + bj * HALF + 4)); } }
            asm volatile("" ::: "memory");
#pragma unroll
            for (int m = 0; m < 4; ++m) { const size_t off = (size_t)(row0 + ai * HALF + m * 16) * ldc + col0;
#pragma unroll
                for (int bj = 0; bj < 2; ++bj) { constexpr float cs = 1.0f / (S_M * S_W); const f32x4 v0 = xb[m][bj][0] + acc[ai][bj][m][0] * cs, v1 = xb[m][bj][1] + acc[ai][bj][m][1] * cs;
                    u32x4 w; w.x = cvt_pk_bf16(v0[0], v0[1]); w.y = cvt_pk_bf16(v0[2], v0[3]); w.z = cvt_pk_bf16(v1[0], v1[1]); w.w = cvt_pk_bf16(v1[2], v1[3]);
                    *(u32x4*)(out + off + bj * HALF) = w; } }
            asm volatile("" ::: "memory"); }
    }
};
struct EpiSwiglu {
    static constexpr bool PERM = true, AFTER_DRAIN = false;
    const float* bgu; bf16_t* ACT;
    __device__ __forceinline__ void operator()(const f32x4 (&acc)[2][2][4][2], const Unit& u, int wr, int wc, int fr, int fq) const {
        const int e = u.pn >> 3, pnl = u.pn & 7, colh = pnl * 128 + wc * 32 + 8 * fq, row0 = u.pm * BM + wr * 64 + fr;
        const float* bg = bgu + (size_t)e * 2048 + colh; const float* bu = bg + 1024;
        const f32x4 bg0 = *(const f32x4*)bg, bg1 = *(const f32x4*)(bg + 4), bu0 = *(const f32x4*)bu, bu1 = *(const f32x4*)(bu + 4);
#pragma unroll
        for (int ai = 0; ai < 2; ++ai)
#pragma unroll
            for (int m = 0; m < 4; ++m) { const size_t row = (size_t)(row0 + ai * HALF + m * 16);
                constexpr float cs = 1.0f / (S_H * S_W);
                const f32x4 g0 = acc[ai][0][m][0] * cs + bg0, g1 = acc[ai][0][m][1] * cs + bg1, u0 = acc[ai][1][m][0] * cs + bu0, u1 = acc[ai][1][m][1] * cs + bu1;
                const float gv[8] = {g0[0], g0[1], g0[2], g0[3], g1[0], g1[1], g1[2], g1[3]}, uv[8] = {u0[0], u0[1], u0[2], u0[3], u1[0], u1[1], u1[2], u1[3]};
                float o[8];
#pragma unroll
                for (int i = 0; i < 8; ++i) { const float gate = fminf(gv[i], 7.0f), up = fminf(fmaxf(uv[i], -7.0f), 7.0f);
                    const float sg = __builtin_amdgcn_rcpf(1.0f + __builtin_amdgcn_exp2f(gate * (-1.702f * 1.4426950408889634f)));
                    o[i] = (up + 1.0f) * (gate * sg); }
                { typedef unsigned u32x2a __attribute__((ext_vector_type(2))); const u32x2a w8 = {pk4_fp8(o[0] * S_A, o[1] * S_A, o[2] * S_A, o[3] * S_A), pk4_fp8(o[4] * S_A, o[5] * S_A, o[6] * S_A, o[7] * S_A)};
                  *(u32x2a*)((unsigned char*)ACT + row * 1024 + colh) = w8; } }
    }
};
struct EpiDown {
    static constexpr bool PERM = true, AFTER_DRAIN = false;
    const float* bd; const int* list; const PG8_LAS int* meta; bf16_t* Y; bf16_t* Y2; int row2;
    __device__ __forceinline__ void operator()(const f32x4 (&acc)[2][2][4][2], const Unit& u, int wr, int wc, int fr, int fq) const {
        const int e = u.pn >> 2, pnl = u.pn & 3, col0 = pnl * 256 + wc * 32 + 8 * fq, rl0 = wr * 64 + fr, slot0 = 256 * (u.pm - meta[MT_BASE + e]), cnt = meta[MT_CNT + e];
        f32x4 b[2][2];
#pragma unroll
        for (int bj = 0; bj < 2; ++bj)
#pragma unroll
            for (int n = 0; n < 2; ++n) b[bj][n] = u.kh == 2 ? (f32x4){0.f, 0.f, 0.f, 0.f} : *(const f32x4*)(bd + (size_t)e * 1024 + col0 + bj * HALF + 4 * n);
        unsigned char* const Yo = u.kh == 2 ? (unsigned char*)Y2 - (size_t)row2 * 1024 : (unsigned char*)Y;
        float rg[2][4];
#pragma unroll
        for (int ai = 0; ai < 2; ++ai)
#pragma unroll
            for (int m = 0; m < 4; ++m) { const int slot = slot0 + rl0 + ai * HALF + m * 16; rg[ai][m] = slot < cnt ? __int_as_float(list[((size_t)e * LISTCAP + slot) * 2 + 1]) : 0.f; }
#pragma unroll
        for (int ai = 0; ai < 2; ++ai)
#pragma unroll
            for (int m = 0; m < 4; ++m) { const size_t row = (size_t)(u.pm * BM + rl0 + ai * HALF + m * 16); const float g = rg[ai][m];
#pragma unroll
                for (int bj = 0; bj < 2; ++bj) { constexpr float cs = 1.0f / (S_A * S_W); const f32x4 v0 = (acc[ai][bj][m][0] * cs + b[bj][0]) * g, v1 = (acc[ai][bj][m][1] * cs + b[bj][1]) * g;
                    typedef unsigned u32x2y __attribute__((ext_vector_type(2))); const u32x2y w = {pk4_fp8(v0[0] * S_Y, v0[1] * S_Y, v0[2] * S_Y, v0[3] * S_Y), pk4_fp8(v1[0] * S_Y, v1[1] * S_Y, v1[2] * S_Y, v1[3] * S_Y)};
                    *(u32x2y*)(Yo + row * 1024 + col0 + bj * HALF) = w; } }
    }
};
struct MoeOrder {
    const PG8_LAS int* tile_e; int ntiles, nN, G, c;
    __device__ __forceinline__ bool next(int i, Unit& u) const {
        const long L = (long)i * G + c; if (L >= (long)ntiles * nN) return false;
        const int t = (int)(L / nN), pnl = (int)(L % nN); u.pm = t; u.pn = tile_e[t] * nN + pnl; u.kh = 0; return true; }
    __device__ __forceinline__ void a_ready(const Unit&) const {}
    __device__ __forceinline__ void done(const Unit&) const {}
};
__host__ __device__ __forceinline__ int moe_split_full(int nunits, int G) { const int full = (nunits / G) * G, rem = nunits - full; return (rem > 0 && 2 * rem <= G) ? full : nunits; }
struct MoeSplitOrder {
    const PG8_LAS int* tile_e; int ntiles, nN, G, c;
    __device__ __forceinline__ bool next(int i, Unit& u) const {
        const int nunits = ntiles * nN, full = moe_split_full(nunits, G); long L = (long)i * G + c; int kh = 0;
        if (L >= full) { const long j = L - full; L = full + (j >> 1); kh = 1 + (int)(j & 1); }
        if (L >= nunits) return false;
        const int t = (int)(L / nN), pnl = (int)(L % nN); u.pm = t; u.pn = tile_e[t] * nN + pnl; u.kh = kh; return true; }
    __device__ __forceinline__ void a_ready(const Unit&) const {}
    __device__ __forceinline__ void done(const Unit&) const {}
};
constexpr float CSIN = 1.0f / (S_H * S_W);
struct EpiInProj {
    static constexpr bool PERM = true, AFTER_DRAIN = false;
    const LAS unsigned char* lds; unsigned char* ws;
    static __device__ __forceinline__ size_t arow(int row, int lg) { const int t = row & (SEQ - 1); return ((size_t)(row >> 11) * (24 * 2048) + (size_t)(((t & ((1 << lg) - 1)) << (11 - lg)) + (t >> lg))) * 64; }
    static __device__ __forceinline__ size_t arow_qk(int row, int lg, int chunk) { const int t = row & (SEQ - 1), pos = ((t & ((1 << lg) - 1)) << (11 - lg)) + (t >> lg);
        return (size_t)(row >> 11) * (24 * 2048 * 64) + (size_t)((pos >> 5) * 2048 + chunk * 256 + (pos & 31) * 8); }
    template <int ROPE> __device__ __forceinline__ void norm_rope(const f32x4 (&acc)[2][2][4][2], int row0, int fq, const float* gain, float scale, bf16_t* dst, int ld, int lg = -1) const {
        float gv[2][2][4];
#pragma unroll
        for (int bj = 0; bj < 2; ++bj)
#pragma unroll
            for (int n = 0; n < 2; ++n)
#pragma unroll
                for (int j = 0; j < 4; ++j) { const int e = 32 * bj + 8 * fq + 4 * n + j; gv[bj][n][j] = gain[ROPE == 0 ? physA(e) : physB(e)] * scale; }
        const f32x2v* ropeA = (const f32x2v*)(ws + WS_TAB + TAB_ROPEA); const f32x2v* rowt = (const f32x2v*)(ws + WS_TAB + TAB_ROW); const f32x2v* colt = (const f32x2v*)(ws + WS_TAB + TAB_COL);
#pragma unroll
        for (int ai = 0; ai < 2; ++ai)
#pragma unroll
            for (int m = 0; m < 4; ++m) { const int row = row0 + ai * HALF + m * 16, t = row & (SEQ - 1);
                float y[2][2][4]; float ss = 0.f;
#pragma unroll
                for (int bj = 0; bj < 2; ++bj)
#pragma unroll
                    for (int n = 0; n < 2; ++n)
#pragma unroll
                        for (int j = 0; j < 4; ++j) { const float v = acc[ai][bj][m][n][j] * CSIN; y[bj][n][j] = v; ss += v * v; }
                ss += __shfl_xor(ss, 16); ss += __shfl_xor(ss, 32);
                const float rstd = 1.f / sqrtf(ss * (1.f / 64.f) + EPS);
#pragma unroll
                for (int bj = 0; bj < 2; ++bj)
#pragma unroll
                    for (int n = 0; n < 2; ++n)
#pragma unroll
                        for (int j = 0; j < 4; ++j) y[bj][n][j] *= rstd * gv[bj][n][j];
                if (ROPE == 0) { const f32x4 cs = *(const f32x4*)(ropeA + t * 8 + 2 * fq);
                    { const float a = y[0][0][0], b = y[0][1][0]; y[0][0][0] = a * cs.x - b * cs.y; y[0][1][0] = b * cs.x + a * cs.y; }
                    { const float a = y[0][0][1], b = y[0][1][1]; y[0][0][1] = a * cs.z - b * cs.w; y[0][1][1] = b * cs.z + a * cs.w; }
                } else {
#pragma unroll
                    for (int bj = 0; bj < 2; ++bj) { const f32x2v* tab = (bj == 0 ? rowt + (t >> 6) * 16 : colt + (t & 63) * 16) + 4 * fq; const f32x4 c01 = *(const f32x4*)tab, c23 = *(const f32x4*)(tab + 2);
                        const float cc[4] = {c01.x, c01.z, c23.x, c23.z}, sn[4] = {c01.y, c01.w, c23.y, c23.w};
#pragma unroll
                        for (int j = 0; j < 4; ++j) { const float a = y[bj][0][j], b = y[bj][1][j]; y[bj][0][j] = a * cc[j] - b * sn[j]; y[bj][1][j] = b * cc[j] + a * sn[j]; } }
                }
#pragma unroll
                for (int bj = 0; bj < 2; ++bj) { if (lg >= 0) { typedef unsigned u32x2q __attribute__((ext_vector_type(2)));
                        const u32x2q w8 = {pk4_fp8(y[bj][0][0], y[bj][0][1], y[bj][0][2], y[bj][0][3]), pk4_fp8(y[bj][1][0], y[bj][1][1], y[bj][1][2], y[bj][1][3])};
                        *(u32x2q*)((unsigned char*)dst + arow_qk(row, lg, 4 * bj + fq)) = w8; continue; }
                    u32x4 w; w.x = cvt_pk_bf16(y[bj][0][0], y[bj][0][1]); w.y = cvt_pk_bf16(y[bj][0][2], y[bj][0][3]); w.z = cvt_pk_bf16(y[bj][1][0], y[bj][1][1]); w.w = cvt_pk_bf16(y[bj][1][2], y[bj][1][3]);
                    *(u32x4*)(dst + (size_t)row * ld + 32 * bj + 8 * fq) = w; } }
    }
    __device__ __forceinline__ void plain(const f32x4 (&acc)[2][2][4][2], int row0, bf16_t* dst, int ld, int colstep) const {
#pragma unroll
        for (int ai = 0; ai < 2; ++ai)
#pragma unroll
            for (int m = 0; m < 4; ++m) { bf16_t* rowp = dst + (size_t)(row0 + ai * HALF + m * 16) * ld;
#pragma unroll
                for (int bj = 0; bj < 2; ++bj) { const f32x4 v0 = acc[ai][bj][m][0] * CSIN, v1 = acc[ai][bj][m][1] * CSIN;
                    u32x4 w; w.x = cvt_pk_bf16(v0[0], v0[1]); w.y = cvt_pk_bf16(v0[2], v0[3]); w.z = cvt_pk_bf16(v1[0], v1[1]); w.w = cvt_pk_bf16(v1[2], v1[3]);
                    *(u32x4*)(rowp + bj * colstep) = w; } }
    }
    __device__ __forceinline__ void operator()(const f32x4 (&acc)[2][2][4][2], const Unit& u, int wr, int wc, int fr, int fq) const {
        const int pn = u.pn, row0 = u.pm * BM + wr * 64 + fr;
        if (pn < 12) {
            const int isk = pn >= 6, v = isk ? pn - 6 : pn, g = v >> 1, head = 4 * (v & 1) + wc;
            bf16_t* dst = (bf16_t*)(ws + (isk ? WS_KA : WS_QA) + (size_t)(g * 8 + head) * (2048 * 64));
            norm_rope<0>(acc, row0, fq, ldptr(lds, isk ? I_KNA : I_QNA) + g * 64, isk ? 0.25f : 4.0f * C2, dst, 0, 2 * g);
        } else if (pn < 18) {
            { const int g = (pn - 12) >> 1, head = ((pn - 12) & 1) * 4 + (wc >> 1), lg = 2 * g;
              unsigned char* dst = ws + WS_VA + (size_t)(g * 8 + head) * (2048 * 64) + (wc & 1) * 32 + 8 * fq;
#pragma unroll
              for (int ai = 0; ai < 2; ++ai)
#pragma unroll
                for (int m = 0; m < 4; ++m) { unsigned char* rowp = dst + arow(row0 + ai * HALF + m * 16, lg);
#pragma unroll
                    for (int bj = 0; bj < 2; ++bj) { const f32x4 v0 = acc[ai][bj][m][0] * CSIN, v1 = acc[ai][bj][m][1] * CSIN;
                        typedef unsigned u32x2v __attribute__((ext_vector_type(2))); const u32x2v w = {pk4_fp8(v0[0], v0[1], v0[2], v0[3]), pk4_fp8(v1[0], v1[1], v1[2], v1[3])};
                        *(u32x2v*)(rowp + (size_t)bj * 2 * (2048 * 64)) = w; } } }
        } else if (pn < 20) {
            norm_rope<1>(acc, row0, fq, ldptr(lds, I_QNB), C2, (bf16_t*)(ws + WS_QB) + (4 * (pn - 18) + wc) * 64, 512);
        } else if (pn == 20) {
            if (wc < 2) norm_rope<1>(acc, row0, fq, ldptr(lds, I_KNB), 1.f, (bf16_t*)(ws + WS_KB) + wc * 64, 128);
            else plain(acc, row0, (bf16_t*)(ws + WS_VB) + (wc - 2) * 64 + 8 * fq, 128, 32);
        } else {
            const int col0 = (pn - 21) * 256 + wc * 32 + 8 * fq; unsigned char* G = (unsigned char*)(ws + WS_GATES); const float* b_gate = ldptr(lds, I_BGATE);
            f32x4 bv[2][2];
#pragma unroll
            for (int bj = 0; bj < 2; ++bj)
#pragma unroll
                for (int n = 0; n < 2; ++n) bv[bj][n] = *(const f32x4*)(b_gate + col0 + bj * HALF + 4 * n);
#pragma unroll
            for (int ai = 0; ai < 2; ++ai)
#pragma unroll
                for (int m = 0; m < 4; ++m) { unsigned char* rowp = G + (size_t)(row0 + ai * HALF + m * 16) * 2048 + col0;
#pragma unroll
                    for (int bj = 0; bj < 2; ++bj) { const f32x4 z0 = acc[ai][bj][m][0] * CSIN + bv[bj][0], z1 = acc[ai][bj][m][1] * CSIN + bv[bj][1];
                        const float z[8] = {z0[0], z0[1], z0[2], z0[3], z1[0], z1[1], z1[2], z1[3]}; unsigned q[8];
#pragma unroll
                        for (int i = 0; i < 8; ++i) q[i] = (unsigned)(255.0f * __builtin_amdgcn_rcpf(1.0f + __builtin_amdgcn_exp2f(z[i] * -1.4426950408889634f)) + 0.5f);
                        typedef unsigned u32x2g __attribute__((ext_vector_type(2)));
                        const u32x2g w = {q[0] | (q[1] << 8) | (q[2] << 16) | (q[3] << 24), q[4] | (q[5] << 8) | (q[6] << 16) | (q[7] << 24)};
                        __builtin_nontemporal_store(w, (u32x2g*)(rowp + bj * HALF)); } }
        }
    }
};
template <class Epi, class Sched, bool ALIGN_EPI = false, bool SP2 = false, bool KSPLIT = false, bool FP8 = false>
__device__ __forceinline__ void gemm_phase(PG8_LAS unsigned char* lds, const Gemm g, const Sched& S, const Epi& E) {
    int tid_ = threadIdx.x; asm volatile("" : "+v"(tid_));
    const int tid = tid_, wid = __builtin_amdgcn_readfirstlane(tid >> 6), lane = tid & 63, wr = wid >> 2, wc = wid & 3, fr = lane & 15, fq = lane >> 4;
    const int K = g.K, nt = K / BK;
    unsigned voffA[2], voffB[2];
#pragma unroll
    for (int i = 0; i < 2; ++i) { int R, C; stage_rc(tid * 16 + i * 8192, R, C); const int Rb = Epi::PERM ? ((R & ~31) + perm32(R & 31)) : R;
        voffA[i] = (unsigned)(R * K + C) * 2u; voffB[i] = (unsigned)(Rb * K + C) * 2u; }
    const size_t kstep = (size_t)(BK * 2);
    const size_t hstep = (size_t)HALF * K * 2;
    const size_t tstep = 2 * hstep;
    const unsigned ldsw = (unsigned)wid * 1024u;
    const int aoff = lds_byte(wr * 64 + fr, fq * 8), boff = lds_byte(wc * 32 + fr, fq * 8);
#define PG8_SA(b, h) (((b) * 2 + (h)) * HTB)
#define PG8_SB(b, h) ((4 + (b) * 2 + (h)) * HTB)
#define PG8_STAGE(bufoff, gbase, voff) do { _Pragma("unroll") for (int _i = 0; _i < 2; ++_i) \
        __builtin_amdgcn_global_load_lds((const unsigned*)((const char*)(gbase) + (voff)[_i]), (PG8_LAS unsigned*)(lds + (bufoff) + ldsw + _i * 8192), 16, 0, 0); } while (0)
#define PG8_LDA(dst, b, h) do { _Pragma("unroll") for (int m = 0; m < 4; ++m) { if constexpr (FP8) dst##8[m] = __builtin_shufflevector(*(const PG8_LAS v4mx*)(lds + PG8_SA(b, h) + aoff + m * 2048), *(const PG8_LAS v4mx*)(lds + PG8_SA(b, h) + aoff + m * 2048 + 1024), 0, 1, 2, 3, 4, 5, 6, 7); else { _Pragma("unroll") for (int k = 0; k < 2; ++k) dst[m][k] = *(const PG8_LAS bf16x8*)(lds + PG8_SA(b, h) + aoff + m * 2048 + k * 1024); } } } while (0)
#define PG8_LDB(dst, b, h) do { _Pragma("unroll") for (int n = 0; n < 2; ++n) { if constexpr (FP8) dst##8[n] = __builtin_shufflevector(*(const PG8_LAS v4mx*)(lds + PG8_SB(b, h) + boff + n * 2048), *(const PG8_LAS v4mx*)(lds + PG8_SB(b, h) + boff + n * 2048 + 1024), 0, 1, 2, 3, 4, 5, 6, 7); else { _Pragma("unroll") for (int k = 0; k < 2; ++k) dst[n][k] = *(const PG8_LAS bf16x8*)(lds + PG8_SB(b, h) + boff + n * 2048 + k * 1024); } } } while (0)
#define PG8_MMA(ai, bj, At, Bt) do { __builtin_amdgcn_s_setprio(1); _Pragma("unroll") for (int m = 0; m < 4; ++m) _Pragma("unroll") for (int n = 0; n < 2; ++n) _Pragma("unroll") for (int k = 0; k < 2; ++k) \
        { if constexpr (FP8) { if (k == 0) asm volatile("v_mfma_f32_16x16x128_f8f6f4 %0, %1, %2, %0" : "+v"(acc[ai][bj][m][n]) : "v"(Bt##8[n]), "v"(At##8[m])); }     \
          else acc[ai][bj][m][n] = __builtin_amdgcn_mfma_f32_16x16x32_bf16(Bt[n][k], At[m][k], acc[ai][bj][m][n], 0, 0, 0); } __builtin_amdgcn_s_setprio(0); } while (0)
#define PG8_WAIT_V(n) asm volatile("s_waitcnt vmcnt(" #n ")" ::: "memory")
#define PG8_WAIT_L(n) asm volatile("s_waitcnt lgkmcnt(" #n ")" ::: "memory")
#define PG8_BAR __builtin_amdgcn_s_barrier()
#define PG8_SCHED __builtin_amdgcn_sched_barrier(0)
    Unit cur, nxt; int ui = 0;
    if (!S.next(0, cur)) return;
    f32x4 acc[2][2][4][2];
#pragma unroll
    for (int a = 0; a < 2; ++a)
#pragma unroll
        for (int b = 0; b < 2; ++b)
#pragma unroll
            for (int m = 0; m < 4; ++m)
#pragma unroll
                for (int n = 0; n < 2; ++n) acc[a][b][m][n] = (f32x4){0.f, 0.f, 0.f, 0.f};
    bf16x8 At[4][2], B0[2][2], B1[2][2];
    typedef int v4mx __attribute__((ext_vector_type(4))); typedef int v8mx __attribute__((ext_vector_type(8)));
    v8mx At8[4], B08[2], B18[2];
    const size_t khoff = (size_t)(K / 2) * 2;
    int ntc = nt; if constexpr (KSPLIT) ntc = cur.kh ? nt / 2 : nt;
    const char* cA = (const char*)g.A + (size_t)cur.pm * tstep; const char* cB = (const char*)g.Bt + (size_t)cur.pn * tstep;
    if constexpr (KSPLIT) { if (cur.kh == 2) { cA += khoff; cB += khoff; } }
    S.a_ready(cur);
    if constexpr (SP2) {
        PG8_STAGE(PG8_SB(0, 0), cB, voffB); PG8_STAGE(PG8_SB(0, 1), cB + hstep, voffB); PG8_STAGE(PG8_SA(0, 0), cA, voffA); PG8_STAGE(PG8_SA(0, 1), cA + hstep, voffA);
        if (wr == 1) PG8_BAR;
        PG8_WAIT_V(2); PG8_BAR;
        PG8_STAGE(PG8_SB(1, 0), cB + kstep, voffB); PG8_STAGE(PG8_SA(1, 0), cA + kstep, voffA); PG8_STAGE(PG8_SB(1, 1), cB + hstep + kstep, voffB);
        PG8_WAIT_V(6); PG8_BAR;
    } else {
        PG8_STAGE(PG8_SB(0, 0), cB, voffB); PG8_STAGE(PG8_SA(0, 0), cA, voffA); PG8_STAGE(PG8_SB(0, 1), cB + hstep, voffB); PG8_STAGE(PG8_SA(0, 1), cA + hstep, voffA);
        if (wr == 1) PG8_BAR;
        PG8_WAIT_V(4); PG8_BAR;
        PG8_STAGE(PG8_SB(1, 0), cB + kstep, voffB); PG8_STAGE(PG8_SA(1, 0), cA + kstep, voffA); PG8_STAGE(PG8_SB(1, 1), cB + hstep + kstep, voffB);
        PG8_WAIT_V(6); PG8_BAR;
    }
    for (;;) {
        const bool has_next = S.next(ui + 1, nxt);
        const char* nA = has_next ? (const char*)g.A + (size_t)nxt.pm * tstep : cA; const char* nB = has_next ? (const char*)g.Bt + (size_t)nxt.pn * tstep : cB;
        if constexpr (KSPLIT) { if (has_next && nxt.kh == 2) { nA += khoff; nB += khoff; } }
        for (int t = 0; t < ntc; t += 2) {
            const bool last = (t == ntc - 2);
            const char* a1 = cA + (size_t)(t + 1) * kstep;
            const char* a2 = last ? nA : cA + (size_t)(t + 2) * kstep; const char* b2 = last ? nB : cB + (size_t)(t + 2) * kstep;
            const char* a3 = a2 + kstep; const char* b3 = b2 + kstep;
            if (last && has_next) S.a_ready(nxt);
            if constexpr (SP2) {
            PG8_LDB(B0, 0, 0); PG8_LDB(B1, 0, 1); PG8_SCHED; PG8_LDA(At, 0, 0); PG8_STAGE(PG8_SA(1, 1), a1 + hstep, voffA);
            PG8_WAIT_V(8); PG8_WAIT_L(0); PG8_BAR; PG8_MMA(0, 0, At, B0); PG8_MMA(0, 1, At, B1); PG8_BAR; PG8_SCHED;
            PG8_LDA(At, 0, 1); PG8_STAGE(PG8_SB(0, 0), b2, voffB); PG8_STAGE(PG8_SB(0, 1), b2 + hstep, voffB); PG8_STAGE(PG8_SA(0, 0), a2, voffA);
            PG8_WAIT_V(8); PG8_WAIT_L(0); PG8_BAR; PG8_MMA(1, 0, At, B0); PG8_MMA(1, 1, At, B1); PG8_BAR; PG8_SCHED;
            PG8_LDB(B0, 1, 0); PG8_LDB(B1, 1, 1); PG8_SCHED; PG8_LDA(At, 1, 0); PG8_STAGE(PG8_SA(0, 1), a2 + hstep, voffA);
            PG8_WAIT_V(8); PG8_WAIT_L(0); PG8_BAR; PG8_MMA(0, 0, At, B0); PG8_MMA(0, 1, At, B1); PG8_BAR; PG8_SCHED;
            PG8_LDA(At, 1, 1); PG8_STAGE(PG8_SB(1, 0), b3, voffB); PG8_STAGE(PG8_SB(1, 1), b3 + hstep, voffB); PG8_STAGE(PG8_SA(1, 0), a3, voffA);
            PG8_WAIT_V(8); PG8_WAIT_L(0); PG8_BAR; PG8_MMA(1, 0, At, B0); PG8_MMA(1, 1, At, B1); PG8_BAR; PG8_SCHED;
            } else {
            PG8_LDB(B0, 0, 0); PG8_SCHED; PG8_LDA(At, 0, 0); PG8_STAGE(PG8_SA(1, 1), a1 + hstep, voffA);
            PG8_WAIT_L(8); PG8_BAR; PG8_WAIT_L(0); PG8_MMA(0, 0, At, B0); PG8_BAR; PG8_SCHED;
            PG8_LDB(B1, 0, 1); PG8_STAGE(PG8_SB(0, 0), b2, voffB);
            PG8_BAR; PG8_WAIT_L(0); PG8_MMA(0, 1, At, B1); PG8_BAR;
            PG8_LDA(At, 0, 1); PG8_STAGE(PG8_SA(0, 0), a2, voffA);
            PG8_BAR; PG8_WAIT_L(0); PG8_MMA(1, 0, At, B0); PG8_BAR; PG8_SCHED;
            PG8_STAGE(PG8_SB(0, 1), b2 + hstep, voffB);
            PG8_WAIT_V(6); PG8_BAR; PG8_MMA(1, 1, At, B1); PG8_BAR;
            PG8_LDB(B0, 1, 0); PG8_SCHED; PG8_LDA(At, 1, 0); PG8_STAGE(PG8_SA(0, 1), a2 + hstep, voffA);
            PG8_WAIT_L(8); PG8_BAR; PG8_WAIT_L(0); PG8_MMA(0, 0, At, B0); PG8_BAR; PG8_SCHED;
            PG8_LDB(B1, 1, 1); PG8_STAGE(PG8_SB(1, 0), b3, voffB);
            PG8_BAR; PG8_WAIT_L(0); PG8_MMA(0, 1, At, B1); PG8_BAR;
            PG8_LDA(At, 1, 1); PG8_STAGE(PG8_SA(1, 0), a3, voffA);
            PG8_BAR; PG8_WAIT_L(0); PG8_MMA(1, 0, At, B0); PG8_BAR; PG8_SCHED;
            PG8_STAGE(PG8_SB(1, 1), b3 + hstep, voffB);
            PG8_WAIT_V(6); PG8_BAR; PG8_MMA(1, 1, At, B1); PG8_BAR;
            }
        }
        if constexpr (ALIGN_EPI) { if (wr == 0) PG8_BAR; }
        if constexpr (FP8) asm volatile("s_nop 15\n\ts_nop 15" ::: "memory");
        if constexpr (!Epi::AFTER_DRAIN) { E(acc, cur, wr, wc, fr, fq); S.done(cur); }
        if (!has_next) break;
#pragma unroll
        for (int a = 0; a < 2; ++a)
#pragma unroll
            for (int b = 0; b < 2; ++b)
#pragma unroll
                for (int m = 0; m < 4; ++m)
#pragma unroll
                    for (int n = 0; n < 2; ++n) acc[a][b][m][n] = (f32x4){0.f, 0.f, 0.f, 0.f};
        cur = nxt; cA = nA; cB = nB; ++ui; if constexpr (KSPLIT) ntc = cur.kh ? nt / 2 : nt;
        if constexpr (ALIGN_EPI) { if (wr == 1) PG8_BAR; }
    }
    PG8_WAIT_V(0);
    if constexpr (!ALIGN_EPI) { if (wr == 0) PG8_BAR; }
    PG8_BAR;
    if constexpr (Epi::AFTER_DRAIN) { E.fused(acc, cur, wr, wc, fr, fq, lds, wid, lane); S.done(cur); }
#undef PG8_SA
#undef PG8_SB
#undef PG8_STAGE
#undef PG8_LDA
#undef PG8_LDB
#undef PG8_MMA
#undef PG8_WAIT_V
#undef PG8_WAIT_L
#undef PG8_BAR
#undef PG8_SCHED
}

template <class Epi, class Sched, bool FP8 = false>
__device__ __forceinline__ void gemm_phase_gather(PG8_LAS unsigned char* lds, const Gemm g, const Sched& S, const Epi& E, const PG8_LAS int* tokTab) {
    int tid_ = threadIdx.x; asm volatile("" : "+v"(tid_));
    const int tid = tid_, wid = __builtin_amdgcn_readfirstlane(tid >> 6), lane = tid & 63, wr = wid >> 2, wc = wid & 3, fr = lane & 15, fq = lane >> 4;
    const int K = g.K, nt = K / BK;
    unsigned voffB[2]; int RA[2], CA[2];
#pragma unroll
    for (int i = 0; i < 2; ++i) { int R, C; stage_rc(tid * 16 + i * 8192, R, C); const int Rb = Epi::PERM ? ((R & ~31) + perm32(R & 31)) : R;
        RA[i] = R; CA[i] = C * 2; voffB[i] = (unsigned)(Rb * K + C) * 2u; }
    unsigned cv0[2], cv1[2], nv0[2], nv1[2];
#define PG8_TOKS(v0, v1, u) do { _Pragma("unroll") for (int _i = 0; _i < 2; ++_i) { v0[_i] = (unsigned)tokTab[(u) * 256 + RA[_i]] * (unsigned)(K * 2) + (unsigned)CA[_i]; v1[_i] = (unsigned)tokTab[(u) * 256 + 128 + RA[_i]] * (unsigned)(K * 2) + (unsigned)CA[_i]; } } while (0)
    const size_t kstep = (size_t)(BK * 2);
    const size_t hstep = (size_t)HALF * K * 2;
    const size_t tstep = 2 * hstep;
    const unsigned ldsw = (unsigned)wid * 1024u;
    const int aoff = lds_byte(wr * 64 + fr, fq * 8), boff = lds_byte(wc * 32 + fr, fq * 8);
#define PG8_SA(b, h) (((b) * 2 + (h)) * HTB)
#define PG8_SB(b, h) ((4 + (b) * 2 + (h)) * HTB)
#define PG8_STAGE(bufoff, gbase, voff) do { _Pragma("unroll") for (int _i = 0; _i < 2; ++_i) \
        __builtin_amdgcn_global_load_lds((const unsigned*)((const char*)(gbase) + (voff)[_i]), (PG8_LAS unsigned*)(lds + (bufoff) + ldsw + _i * 8192), 16, 0, 0); } while (0)
#define PG8_LDA(dst, b, h) do { _Pragma("unroll") for (int m = 0; m < 4; ++m) { if constexpr (FP8) dst##8[m] = __builtin_shufflevector(*(const PG8_LAS v4mx*)(lds + PG8_SA(b, h) + aoff + m * 2048), *(const PG8_LAS v4mx*)(lds + PG8_SA(b, h) + aoff + m * 2048 + 1024), 0, 1, 2, 3, 4, 5, 6, 7); else { _Pragma("unroll") for (int k = 0; k < 2; ++k) dst[m][k] = *(const PG8_LAS bf16x8*)(lds + PG8_SA(b, h) + aoff + m * 2048 + k * 1024); } } } while (0)
#define PG8_LDB(dst, b, h) do { _Pragma("unroll") for (int n = 0; n < 2; ++n) { if constexpr (FP8) dst##8[n] = __builtin_shufflevector(*(const PG8_LAS v4mx*)(lds + PG8_SB(b, h) + boff + n * 2048), *(const PG8_LAS v4mx*)(lds + PG8_SB(b, h) + boff + n * 2048 + 1024), 0, 1, 2, 3, 4, 5, 6, 7); else { _Pragma("unroll") for (int k = 0; k < 2; ++k) dst[n][k] = *(const PG8_LAS bf16x8*)(lds + PG8_SB(b, h) + boff + n * 2048 + k * 1024); } } } while (0)
#define PG8_MMA(ai, bj, At, Bt) do { __builtin_amdgcn_s_setprio(1); _Pragma("unroll") for (int m = 0; m < 4; ++m) _Pragma("unroll") for (int n = 0; n < 2; ++n) _Pragma("unroll") for (int k = 0; k < 2; ++k) \
        { if constexpr (FP8) { if (k == 0) asm volatile("v_mfma_f32_16x16x128_f8f6f4 %0, %1, %2, %0" : "+v"(acc[ai][bj][m][n]) : "v"(Bt##8[n]), "v"(At##8[m])); }     \
          else acc[ai][bj][m][n] = __builtin_amdgcn_mfma_f32_16x16x32_bf16(Bt[n][k], At[m][k], acc[ai][bj][m][n], 0, 0, 0); } __builtin_amdgcn_s_setprio(0); } while (0)
#define PG8_WAIT_V(n) asm volatile("s_waitcnt vmcnt(" #n ")" ::: "memory")
#define PG8_WAIT_L(n) asm volatile("s_waitcnt lgkmcnt(" #n ")" ::: "memory")
#define PG8_BAR __builtin_amdgcn_s_barrier()
#define PG8_SCHED __builtin_amdgcn_sched_barrier(0)
    Unit cur, nxt; int ui = 0;
    if (!S.next(0, cur)) return;
    f32x4 acc[2][2][4][2];
#pragma unroll
    for (int a = 0; a < 2; ++a)
#pragma unroll
        for (int b = 0; b < 2; ++b)
#pragma unroll
            for (int m = 0; m < 4; ++m)
#pragma unroll
                for (int n = 0; n < 2; ++n) acc[a][b][m][n] = (f32x4){0.f, 0.f, 0.f, 0.f};
    bf16x8 At[4][2], B0[2][2], B1[2][2];
    typedef int v4mx __attribute__((ext_vector_type(4))); typedef int v8mx __attribute__((ext_vector_type(8)));
    v8mx At8[4], B08[2], B18[2];
    const char* const cA = (const char*)g.A; const char* cB = (const char*)g.Bt + (size_t)cur.pn * tstep;
    PG8_TOKS(cv0, cv1, 0);
    PG8_STAGE(PG8_SB(0, 0), cB, voffB); PG8_STAGE(PG8_SB(0, 1), cB + hstep, voffB); PG8_STAGE(PG8_SA(0, 0), cA, cv0); PG8_STAGE(PG8_SA(0, 1), cA, cv1);
    if (wr == 1) PG8_BAR;
    PG8_WAIT_V(2); PG8_BAR;
    PG8_STAGE(PG8_SB(1, 0), cB + kstep, voffB); PG8_STAGE(PG8_SA(1, 0), cA + kstep, cv0); PG8_STAGE(PG8_SB(1, 1), cB + hstep + kstep, voffB);
    PG8_WAIT_V(6); PG8_BAR;
    for (;;) {
        const bool has_next = S.next(ui + 1, nxt);
        if (has_next) PG8_TOKS(nv0, nv1, ui + 1); else { nv0[0] = cv0[0]; nv0[1] = cv0[1]; nv1[0] = cv1[0]; nv1[1] = cv1[1]; }
        const char* nB = has_next ? (const char*)g.Bt + (size_t)nxt.pn * tstep : cB;
        for (int t = 0; t < nt; t += 2) {
            const bool last = (t == nt - 2);
            const char* a1 = cA + (size_t)(t + 1) * kstep;
            const char* a2 = last ? cA : cA + (size_t)(t + 2) * kstep; const char* b2 = last ? nB : cB + (size_t)(t + 2) * kstep;
            const char* a3 = a2 + kstep; const char* b3 = b2 + kstep;
            unsigned x0[2], x1[2];
            x0[0] = last ? nv0[0] : cv0[0]; x0[1] = last ? nv0[1] : cv0[1]; x1[0] = last ? nv1[0] : cv1[0]; x1[1] = last ? nv1[1] : cv1[1];
            PG8_LDB(B0, 0, 0); PG8_LDB(B1, 0, 1); PG8_SCHED; PG8_LDA(At, 0, 0); PG8_STAGE(PG8_SA(1, 1), a1, cv1);
            PG8_WAIT_V(8); PG8_WAIT_L(0); PG8_BAR; PG8_MMA(0, 0, At, B0); PG8_MMA(0, 1, At, B1); PG8_BAR; PG8_SCHED;
            PG8_LDA(At, 0, 1); PG8_STAGE(PG8_SB(0, 0), b2, voffB); PG8_STAGE(PG8_SB(0, 1), b2 + hstep, voffB); PG8_STAGE(PG8_SA(0, 0), a2, x0);
            PG8_WAIT_V(8); PG8_WAIT_L(0); PG8_BAR; PG8_MMA(1, 0, At, B0); PG8_MMA(1, 1, At, B1); PG8_BAR; PG8_SCHED;
            PG8_LDB(B0, 1, 0); PG8_LDB(B1, 1, 1); PG8_SCHED; PG8_LDA(At, 1, 0); PG8_STAGE(PG8_SA(0, 1), a2, x1);
            PG8_WAIT_V(8); PG8_WAIT_L(0); PG8_BAR; PG8_MMA(0, 0, At, B0); PG8_MMA(0, 1, At, B1); PG8_BAR; PG8_SCHED;
            PG8_LDA(At, 1, 1); PG8_STAGE(PG8_SB(1, 0), b3, voffB); PG8_STAGE(PG8_SB(1, 1), b3 + hstep, voffB); PG8_STAGE(PG8_SA(1, 0), a3, x0);
            PG8_WAIT_V(8); PG8_WAIT_L(0); PG8_BAR; PG8_MMA(1, 0, At, B0); PG8_MMA(1, 1, At, B1); PG8_BAR; PG8_SCHED;
        }
        if (wr == 0) PG8_BAR;
        if constexpr (FP8) asm volatile("s_nop 15\n\ts_nop 15" ::: "memory");
        E(acc, cur, wr, wc, fr, fq);
        if (!has_next) break;
#pragma unroll
        for (int a = 0; a < 2; ++a)
#pragma unroll
            for (int b = 0; b < 2; ++b)
#pragma unroll
                for (int m = 0; m < 4; ++m)
#pragma unroll
                    for (int n = 0; n < 2; ++n) acc[a][b][m][n] = (f32x4){0.f, 0.f, 0.f, 0.f};
        cur = nxt; cB = nB; ++ui;
        cv0[0] = nv0[0]; cv0[1] = nv0[1]; cv1[0] = nv1[0]; cv1[1] = nv1[1];
        if (wr == 1) PG8_BAR;
    }
    PG8_WAIT_V(0);
    PG8_BAR;
#undef PG8_TOKS
#undef PG8_SA
#undef PG8_SB
#undef PG8_STAGE
#undef PG8_LDA
#undef PG8_LDB
#undef PG8_MMA
#undef PG8_WAIT_V
#undef PG8_WAIT_L
#undef PG8_BAR
#undef PG8_SCHED
}
}
#include <hip/hip_bf16.h>
#include <cmath>
namespace attn_body {
using bf16=__hip_bfloat16;
using bf16x8=__attribute__((ext_vector_type(8)))short;
using s16x4=__attribute__((ext_vector_type(4)))short;
using f32x16=__attribute__((ext_vector_type(16)))float;
using u32x4=__attribute__((ext_vector_type(4)))unsigned;
constexpr int BATCH=8,NHEAD=8,SEQ=2048,D=64,QP=512,KP=128;
constexpr int NW=8,QBLK=32,QB=QBLK*NW,KVBLK=64,NQB=SEQ/QB;
constexpr int ATTN_UNIT_ROWS=QB;
__device__ __forceinline__ int crow(int r,int hi){return (r&3)+8*(r>>2)+4*hi;}
#define SBAR() __builtin_amdgcn_sched_barrier(0)
__device__ __forceinline__ void cmask(f32x16&p0,f32x16&p1,int jb,int qrel,int hi){
  const float NEG=-INFINITY; int kb=64*jb+4*hi;
  #pragma unroll
  for(int r=0;r<16;++r){int kv=kb+(r&3)+8*(r>>2); if(kv>qrel)p0[r]=NEG; if(kv+32>qrel)p1[r]=NEG;}
}

constexpr int NSLOT=3, SLOTB=8192;
constexpr int LDS_K=0, LDS_V=NSLOT*SLOTB, LDS_WS=2*NSLOT*SLOTB, LDS_OST=LDS_WS+NW*64*4, LDS_BYTES=LDS_OST+NW*4096;
constexpr float C2=0.125f*1.4426950408889634f;
__device__ __forceinline__ void glds16(const void*gsrc,unsigned lds_dst){unsigned keep;
  asm volatile("s_mov_b32 %0, m0\n\ts_mov_b32 m0, %2\n\ts_nop 0\n\tglobal_load_lds_dwordx4 %1, off\n\ts_mov_b32 m0, %0":"=&s"(keep):"v"(gsrc),"s"(lds_dst):"memory");}
__device__ __forceinline__ float max3f(float a,float b,float c){float r;asm("v_max3_f32 %0, %1, %2, %3":"=v"(r):"v"(a),"v"(b),"v"(c));return r;}
__device__ __forceinline__ float max2f(float a,float b){float r;asm("v_max_f32_e32 %0, %1, %2":"=v"(r):"v"(a),"v"(b));return r;}
__device__ __forceinline__ float fadd_s(float a,float b){float r;asm("v_add_f32_e32 %0, %1, %2":"=v"(r):"v"(a),"v"(b));return r;}
__device__ __forceinline__ float fsub_s(float a,float b){float r;asm("v_sub_f32_e32 %0, %1, %2":"=v"(r):"v"(a),"v"(b));return r;}
typedef float f32x2_t __attribute__((ext_vector_type(2))); typedef __bf16 bf16x2_t __attribute__((ext_vector_type(2)));
__device__ __forceinline__ unsigned cvtpk_s(float lo,float hi){f32x2_t v={lo,hi};bf16x2_t b=__builtin_convertvector(v,bf16x2_t);return __builtin_bit_cast(unsigned,b);}
#define WAIT_BAR(N) asm volatile("s_waitcnt vmcnt(" #N ") lgkmcnt(0)\n\ts_barrier":::"memory")

__device__ __forceinline__ void qkt(f32x16&p0,f32x16&p1,const char*Kslot,const bf16x8*qr,const f32x16&negm,int r32,int hi){
  const char*kb=Kslot+hi*1024+r32*16;
  #pragma unroll
  for(int d0=0;d0<4;++d0){
    const bf16x8 b0=*reinterpret_cast<const bf16x8*>(kb+d0*2048);
    const bf16x8 b1=*reinterpret_cast<const bf16x8*>(kb+d0*2048+512);
    if(d0==0){p0=__builtin_amdgcn_mfma_f32_32x32x16_bf16(b0,qr[0],negm,0,0,0);p1=__builtin_amdgcn_mfma_f32_32x32x16_bf16(b1,qr[0],negm,0,0,0);}
    else{p0=__builtin_amdgcn_mfma_f32_32x32x16_bf16(b0,qr[d0],p0,0,0,0);p1=__builtin_amdgcn_mfma_f32_32x32x16_bf16(b1,qr[d0],p1,0,0,0);}}
}
typedef __attribute__((address_space(3))) const char* lds_cptr;
typedef short v4i16_t __attribute__((ext_vector_type(4)));
__device__ __forceinline__ void kload8(bf16x8*kf,lds_cptr kp){
  kf[0]=*(const __attribute__((address_space(3))) bf16x8*)(kp);      kf[1]=*(const __attribute__((address_space(3))) bf16x8*)(kp+512);
  kf[2]=*(const __attribute__((address_space(3))) bf16x8*)(kp+2048); kf[3]=*(const __attribute__((address_space(3))) bf16x8*)(kp+2560);
  kf[4]=*(const __attribute__((address_space(3))) bf16x8*)(kp+4096); kf[5]=*(const __attribute__((address_space(3))) bf16x8*)(kp+4608);
  kf[6]=*(const __attribute__((address_space(3))) bf16x8*)(kp+6144); kf[7]=*(const __attribute__((address_space(3))) bf16x8*)(kp+6656);
}
__device__ __forceinline__ void kload2(bf16x8*kf,lds_cptr kp,int j){ kf[2*j]=*(const __attribute__((address_space(3))) bf16x8*)(kp+j*2048); kf[2*j+1]=*(const __attribute__((address_space(3))) bf16x8*)(kp+j*2048+512); }
__device__ __forceinline__ s16x4 vtr(lds_cptr p){ return __builtin_bit_cast(s16x4,__builtin_amdgcn_ds_read_tr16_b64_v4i16((__attribute__((address_space(3))) v4i16_t*)p)); }
__device__ __forceinline__ float rowmax(const f32x16&p0,const f32x16&p1){
  float a=max3f(p0[0],p0[1],p1[0]),b=max3f(p0[2],p0[3],p1[1]);a=max3f(a,p1[2],p1[3]);
  #pragma unroll
  for(int r=4;r<16;r+=4){a=max3f(a,p0[r],p0[r+1]);b=max3f(b,p0[r+2],p0[r+3]);a=max3f(a,p1[r],p1[r+1]);b=max3f(b,p1[r+2],p1[r+3]);}
  const float m=max2f(a,b);
  auto rr=__builtin_amdgcn_permlane32_swap(__float_as_uint(m),__float_as_uint(m),false,false);
  return max2f(__uint_as_float(rr[0]),__uint_as_float(rr[1]));
}
__device__ __forceinline__ void pv(f32x16*o,int vb,bf16x8 pa0,bf16x8 pa1,bf16x8 pa2,bf16x8 pa3){
  #pragma unroll
  for(int d0=0;d0<2;++d0){s16x4 lo[4],hi[4];
    #pragma unroll
    for(int ks=0;ks<4;++ks){
      asm volatile("ds_read_b64_tr_b16 %0,%1 offset:%c2":"=&v"(lo[ks]):"v"(vb),"i"(d0*4096+ks*1024):"memory");
      asm volatile("ds_read_b64_tr_b16 %0,%1 offset:%c2":"=&v"(hi[ks]):"v"(vb),"i"(d0*4096+ks*1024+512):"memory");}
    asm volatile("s_waitcnt lgkmcnt(0)":::"memory");SBAR();
    #define PK(k) (bf16x8){lo[k][0],lo[k][1],lo[k][2],lo[k][3],hi[k][0],hi[k][1],hi[k][2],hi[k][3]}
    o[d0]=__builtin_amdgcn_mfma_f32_32x32x16_bf16(pa0,PK(0),o[d0],0,0,0);
    o[d0]=__builtin_amdgcn_mfma_f32_32x32x16_bf16(pa1,PK(1),o[d0],0,0,0);
    o[d0]=__builtin_amdgcn_mfma_f32_32x32x16_bf16(pa2,PK(2),o[d0],0,0,0);
    o[d0]=__builtin_amdgcn_mfma_f32_32x32x16_bf16(pa3,PK(3),o[d0],0,0,0);
    #undef PK
  }
}

#ifndef ATTN_STORE16
#define ATTN_STORE16(p,v) (*(u32x4*)(p)=(v))
#endif
__device__ __forceinline__ void attn_unit(int b,int h,int qb,const bf16*Q,const bf16*__restrict__ K,const bf16*__restrict__ V,bf16*O,char*shm,float M0){
  const int tid=threadIdx.x,lane=tid&63,r32=lane&31,hi=lane>>5; const int wid=__builtin_amdgcn_readfirstlane(tid>>6);
  const long rowbase=(long)b*SEQ; const int q0=qb*QB;
  const bf16*Qw=Q+(rowbase+q0+wid*QBLK)*QP+h*D;
  const bf16*Kh=K+rowbase*KP+(h>>2)*D,*Vh=V+rowbase*KP+(h>>2)*D;
  const unsigned lds0=(unsigned)(uintptr_t)shm;
  float*wsf=(float*)(shm+LDS_WS)+wid*64;
  const bf16*ksrc=Kh+(long)lane*KP+wid*8;
  const bf16*vsrc=Vh+(long)(16*(wid&3)+(lane>>2))*KP+(wid>>2)*32+(lane&3)*8;
  const unsigned kdst=lds0+LDS_K+wid*1024, vdst=lds0+LDS_V+wid*1024;
  #define DMA_K(t,slot) glds16(ksrc+(long)(t)*KVBLK*KP,(unsigned)__builtin_amdgcn_readfirstlane(kdst+(slot)))
  #define DMA_V(t,slot) glds16(vsrc+(long)(t)*KVBLK*KP,(unsigned)__builtin_amdgcn_readfirstlane(vdst+(slot)))
  const int vb0=(int)(lds0+LDS_V)+((lane>>4)&1)*32+(lane&3)*8+(4*hi+((lane&15)>>2))*64;
  const char*Kbase=shm+LDS_K; bf16x8 kf[8];
  const lds_cptr shm3=(lds_cptr)shm; const lds_cptr kp0=shm3+LDS_K+hi*1024+r32*16; const lds_cptr vp0=shm3+LDS_V+((lane>>4)&1)*32+(lane&3)*8+(4*hi+((lane&15)>>2))*64;
  constexpr int NT=SEQ/KVBLK;
  DMA_K(0,0);DMA_V(0,0);DMA_K(1,SLOTB);
  bf16x8 qr[4];
  #pragma unroll
  for(int d0=0;d0<4;++d0)qr[d0]=*reinterpret_cast<const bf16x8*>(&Qw[(long)r32*QP+d0*16+hi*8]);
  float l_reg=0.f;f32x16 o[2];o[0]=f32x16{};o[1]=f32x16{};f32x16 negm;
  #pragma unroll
  for(int r=0;r<16;++r)negm[r]=-M0;
  asm volatile("":"+v"(negm));
  #define CMASK(P0,P1,t) do{}while(0)
  #define START(P0,P1) do{ _Pragma("unroll") for(int r=0;r<16;++r)P0[r]=__builtin_amdgcn_exp2f(P0[r]); }while(0)
  #define RESC() do{}while(0)
  f32x16 pA0,pA1,pB0,pB1;
  int sl_prev=0,sl_cur=0,sl_next=SLOTB;
  #define ROT() do{sl_prev=sl_cur;sl_cur=sl_next;sl_next=(sl_next==(NSLOT-1)*SLOTB)?0:sl_next+SLOTB;}while(0)
  DMA_K(2,2*SLOTB);
  WAIT_BAR(3);
  qkt(pA0,pA1,Kbase,qr,negm,r32,hi);asm volatile("s_nop 15\n\ts_nop 7":"+v"(pA0),"+v"(pA1));CMASK(pA0,pA1,0);
  START(pA0,pA1);
  _Pragma("unroll") for(int r=0;r<16;++r)pA1[r]=__builtin_amdgcn_exp2f(pA1[r]);
  WAIT_BAR(0);
  DMA_K(3,0);DMA_V(1,SLOTB);
  ROT();
  kload8(kf,kp0+sl_cur);
  WAIT_BAR(2);
  s16x4 vlo[8],vhi[8]; u32x4 pw0,pw1,pw2,pw3;
  #define PKW(P,B) cvtpk_s(P[B],P[B+1])
  #define PAF(k) __builtin_bit_cast(bf16x8,pw##k)
  #define VFR(i) (bf16x8){vlo[i][0],vlo[i][1],vlo[i][2],vlo[i][3],vhi[i][0],vhi[i][1],vhi[i][2],vhi[i][3]}
  #define PIN(x) asm volatile("":"+v"(x))
  #define MX3(a,b,c) __builtin_fmaxf(__builtin_fmaxf((a),(b)),(c))
  #define GAPA(MF,A0,A1,A2,A3,W0,W1,PW) do{ MF; sacc+=A0; sacc+=A1; sacc+=A2; sacc+=A3; PIN(sacc); W0; W1; PIN(PW); SBAR(); }while(0)
  #define EX(v) __builtin_amdgcn_exp2f(v)
  #define GAPB(MF,X,B) do{ MF; X[B]=EX(X[B]); X[B+1]=EX(X[B+1]); X[B+2]=EX(X[B+2]); X[B+3]=EX(X[B+3]); PIN(X); SBAR(); }while(0)
  #define VRD(i) do{ vlo[i]=vtr(vp_+(((i)>>2)*4096+((i)&3)*1024)); vhi[i]=vtr(vp_+(((i)>>2)*4096+((i)&3)*1024+512)); }while(0)
  #define KRD(G,j) do{ if(G){ kload2(kf,kp0+sl_next,j); SBAR(); } }while(0)
  #define STEP(C0,C1,P0,P1,t,GK,GV,GL) do{ SBAR(); \
    const lds_cptr vp_=vp0+sl_prev; \
    VRD(0); SBAR(); float sacc=(P0[0]+P0[1]); \
    GAPA(C0=__builtin_amdgcn_mfma_f32_32x32x16_bf16(kf[0],qr[0],negm,0,0,0), P0[2],P0[3],P0[4],P0[5],     pw0[0]=PKW(P0,0), pw0[1]=PKW(P0,2), pw0); \
    VRD(4); SBAR(); GAPA(C1=__builtin_amdgcn_mfma_f32_32x32x16_bf16(kf[1],qr[0],negm,0,0,0), P0[6],P0[7],P0[8],P0[9],     pw0[2]=PKW(P0,4), pw0[3]=PKW(P0,6), pw0); \
    VRD(1); SBAR(); GAPA(C0=__builtin_amdgcn_mfma_f32_32x32x16_bf16(kf[2],qr[1],C0,0,0,0),   P0[10],P0[11],P0[12],P0[13], pw1[0]=PKW(P0,8), pw1[1]=PKW(P0,10), pw1); \
    VRD(5); SBAR(); GAPA(C1=__builtin_amdgcn_mfma_f32_32x32x16_bf16(kf[3],qr[1],C1,0,0,0),   P0[14],P0[15],P1[0],P1[1],   pw1[2]=PKW(P0,12),pw1[3]=PKW(P0,14), pw1); \
    VRD(2); SBAR(); GAPA(C0=__builtin_amdgcn_mfma_f32_32x32x16_bf16(kf[4],qr[2],C0,0,0,0),   P1[2],P1[3],P1[4],P1[5],     pw2[0]=PKW(P1,0), pw2[1]=PKW(P1,2), pw2); \
    VRD(6); SBAR(); GAPA(C1=__builtin_amdgcn_mfma_f32_32x32x16_bf16(kf[5],qr[2],C1,0,0,0),   P1[6],P1[7],P1[8],P1[9],     pw2[2]=PKW(P1,4), pw2[3]=PKW(P1,6), pw2); \
    VRD(3); SBAR(); GAPA(C0=__builtin_amdgcn_mfma_f32_32x32x16_bf16(kf[6],qr[3],C0,0,0,0),   P1[10],P1[11],P1[12],P1[13], pw3[0]=PKW(P1,8), pw3[1]=PKW(P1,10), pw3); \
    VRD(7); SBAR(); GAPA(C1=__builtin_amdgcn_mfma_f32_32x32x16_bf16(kf[7],qr[3],C1,0,0,0),   P1[14],P1[15],0.f,0.f,       pw3[2]=PKW(P1,12),pw3[3]=PKW(P1,14), pw3); \
    l_reg+=sacc; \
    if(GK){DMA_K((t)+3,sl_cur);} if(GV){DMA_V((t)+1,sl_next);} \
    CMASK(C0,C1,t); \
    SBAR(); \
    GAPB(o[0]=__builtin_amdgcn_mfma_f32_32x32x16_bf16(PAF(0),VFR(0),o[0],0,0,0), C0,0); \
    GAPB(o[1]=__builtin_amdgcn_mfma_f32_32x32x16_bf16(PAF(0),VFR(4),o[1],0,0,0), C0,4); \
    KRD(GL,0); GAPB(o[0]=__builtin_amdgcn_mfma_f32_32x32x16_bf16(PAF(1),VFR(1),o[0],0,0,0), C0,8); \
    KRD(GL,1); GAPB(o[1]=__builtin_amdgcn_mfma_f32_32x32x16_bf16(PAF(1),VFR(5),o[1],0,0,0), C0,12); \
    KRD(GL,2); GAPB(o[0]=__builtin_amdgcn_mfma_f32_32x32x16_bf16(PAF(2),VFR(2),o[0],0,0,0), C1,0); \
    KRD(GL,3); GAPB(o[1]=__builtin_amdgcn_mfma_f32_32x32x16_bf16(PAF(2),VFR(6),o[1],0,0,0), C1,4); \
    GAPB(o[0]=__builtin_amdgcn_mfma_f32_32x32x16_bf16(PAF(3),VFR(3),o[0],0,0,0), C1,8); \
    GAPB(o[1]=__builtin_amdgcn_mfma_f32_32x32x16_bf16(PAF(3),VFR(7),o[1],0,0,0), C1,12); \
    }while(0)
  int t=1;
  for(;t+5<NT;t+=2){
    STEP(pB0,pB1,pA0,pA1,t,true,true,true);     WAIT_BAR(2); RESC(); ROT();
    STEP(pA0,pA1,pB0,pB1,t+1,true,true,true);   WAIT_BAR(2); RESC(); ROT();
  }
  #define ENDW(tt) do{ if((tt)+3<NT){WAIT_BAR(2);} else if((tt)+2<NT){WAIT_BAR(1);} else {WAIT_BAR(0);} }while(0)
  for(;t+1<NT;t+=2){
    STEP(pB0,pB1,pA0,pA1,t,(t+3<NT),(t+1<NT),(t+1<NT));       ENDW(t);   RESC(); ROT();
    STEP(pA0,pA1,pB0,pB1,t+1,(t+4<NT),(t+2<NT),(t+2<NT));     ENDW(t+1); RESC(); ROT();
  }
  STEP(pB0,pB1,pA0,pA1,NT-1,false,false,false); RESC();
  { float sacc=pB0[0]+pB0[1]; _Pragma("unroll") for(int r=2;r<16;++r)sacc+=pB0[r]; _Pragma("unroll") for(int r=0;r<16;++r)sacc+=pB1[r]; l_reg+=sacc;
    pw0=(u32x4){PKW(pB0,0),PKW(pB0,2),PKW(pB0,4),PKW(pB0,6)};pw1=(u32x4){PKW(pB0,8),PKW(pB0,10),PKW(pB0,12),PKW(pB0,14)};pw2=(u32x4){PKW(pB1,0),PKW(pB1,2),PKW(pB1,4),PKW(pB1,6)};pw3=(u32x4){PKW(pB1,8),PKW(pB1,10),PKW(pB1,12),PKW(pB1,14)};
    SBAR(); pv(o,vb0+sl_cur,PAF(0),PAF(1),PAF(2),PAF(3)); }
  #undef PKW
  #undef PAF
  #undef VFR
  #undef PIN
  #undef MX3
  #undef GAPA
  #undef GAPB
  #undef EX
  #undef VRD
  #undef KRD
  #undef STEP
  #undef ENDW
  {auto rr=__builtin_amdgcn_permlane32_swap(__float_as_uint(l_reg),__float_as_uint(l_reg),false,false);l_reg=__uint_as_float(rr[0])+__uint_as_float(rr[1]);}
  if(hi==0)wsf[32+r32]=l_reg;asm volatile("s_waitcnt lgkmcnt(0)":::"memory");
  float rli[16];
  #pragma unroll
  for(int r=0;r<16;++r)rli[r]=__builtin_amdgcn_rcpf(wsf[32+crow(r,hi)]);
  bf16*Ow=O+(rowbase+q0+wid*QBLK)*QP+h*D;
  { bf16*stg=(bf16*)(shm+LDS_OST)+wid*2048;
    #pragma unroll
    for(int r=0;r<16;++r){const int orow=crow(r,hi);
      #pragma unroll
      for(int d0=0;d0<2;++d0)stg[orow*64+d0*32+r32]=__float2bfloat16(o[d0][r]*rli[r]);}
    asm volatile("s_waitcnt lgkmcnt(0)":::"memory");
    #pragma unroll
    for(int i=0;i<4;++i){const int row=i*8+(lane>>3),ch=lane&7; const u32x4 v=*(const u32x4*)(stg+row*64+ch*8);
      typedef unsigned u32x2o __attribute__((ext_vector_type(2))); const u32x2o w8={pk4_fp8(__uint_as_float(v.x<<16)*S_O,__uint_as_float(v.x&0xffff0000u)*S_O,__uint_as_float(v.y<<16)*S_O,__uint_as_float(v.y&0xffff0000u)*S_O),pk4_fp8(__uint_as_float(v.z<<16)*S_O,__uint_as_float(v.z&0xffff0000u)*S_O,__uint_as_float(v.w<<16)*S_O,__uint_as_float(v.w&0xffff0000u)*S_O)};
      *(u32x2o*)((unsigned char*)O+((rowbase+q0+wid*QBLK)*QP+h*D)+(long)row*QP+ch*8)=w8;} }
  asm volatile("s_waitcnt lgkmcnt(0)\n\ts_barrier":::"memory");
  #undef DMA_K
  #undef DMA_V
  #undef CMASK
  #undef START
  #undef RESC
  #undef ROT
}
constexpr int ATTN_LDS_BYTES=LDS_BYTES;
struct AttnTensors { const bf16* Q; const bf16* K; const bf16* V; bf16* O; };
struct AttnUnit { int bh; int qb; };
struct StaticOrder {
  int vcu,G;
  __device__ __forceinline__ explicit StaticOrder(int grid,int block):vcu((grid%8==0)?(block%8)*(grid/8)+block/8:block),G(grid){}
  __device__ __forceinline__ bool next(int i,AttnUnit&u)const{ const int L=vcu*2+i; if(i>=2&&G==256)return false; if(G==256){u.bh=(L>>6)*8+((L&63)>>3); u.qb=L&7; return true;}
    const int L2=i*G+vcu; if(L2>=BATCH*NHEAD*NQB)return false; u.bh=L2>>3; u.qb=L2&7; return true; }
};
template<class Sched> __device__ __forceinline__ void attn_phase(char*lds,const AttnTensors&T,const Sched&S,float M0){
  AttnUnit u;
  for(int i=0;S.next(i,u);++i){ attn_unit(u.bh/NHEAD,u.bh%NHEAD,u.qb,T.Q,T.K,T.V,T.O,lds,M0); }
}
#undef SBAR
#undef WAIT_BAR
}
#define XB_TMO      128
#define XB_XCNT(j)  (256  + 64 * (j))
#define XB_XSUB(j)  (1280 + 64 * (j))
#define XB_XGEN(j)  (2304 + 64 * (j))
#define XB_TOP      3328
#define XB_TOPGEN   3392
#define XCD_BAR_WORDS 3456
#define XB_SPIN_CAP (1u << 18)

__device__ __forceinline__ unsigned xb_ld(unsigned* p)              { return __hip_atomic_load(p, __ATOMIC_RELAXED, __HIP_MEMORY_SCOPE_AGENT); }
__device__ __forceinline__ unsigned xb_add(unsigned* p, unsigned v) { return __hip_atomic_fetch_add(p, v, __ATOMIC_RELAXED, __HIP_MEMORY_SCOPE_AGENT); }
__device__ __forceinline__ unsigned xb_xcc_id() { return (unsigned)__builtin_amdgcn_s_getreg((3 << 11) | 20) & 0xFu; }
#define XB_SPIN(cond, bar) do { unsigned _sp = 0; while (cond) { __builtin_amdgcn_s_sleep(1); \
    if ((++_sp & 255u) == 0u) { if (xb_ld(&(bar)[XB_TMO])) break; if (_sp > XB_SPIN_CAP) { atomicAdd(&(bar)[XB_TMO], 1u); break; } } } } while (0)

struct XcdBarrier {
    unsigned* bar; unsigned x;
    volatile LAS unsigned* st;
};

__device__ __forceinline__ XcdBarrier xcd_barrier_post(unsigned* bar, volatile LAS unsigned* st) {
    XcdBarrier b; b.bar = bar; b.x = xb_xcc_id(); b.st = st;
    if (threadIdx.x == 0) (void)xb_add(&bar[XB_XCNT(b.x)], 1u);
    return b;
}
__device__ __forceinline__ void xcd_barrier_complete(unsigned* bar, unsigned x, unsigned& nloc, unsigned& nx) {
    const unsigned G = gridDim.x * gridDim.y * gridDim.z;
    unsigned sum, cnt, mine, sp = 0u;
    for (;;) {
        sum = 0u; cnt = 0u; mine = 0u;
#pragma unroll
        for (unsigned j = 0; j < 16; ++j) { const unsigned c = xb_ld(&bar[XB_XCNT(j)]); sum += c; cnt += (c > 0u) ? 1u : 0u; mine = (j == x) ? c : mine; }
        if (sum == G) break;
        __builtin_amdgcn_s_sleep(1);
        if ((++sp & 255u) == 0u) { if (xb_ld(&bar[XB_TMO])) break; if (sp > XB_SPIN_CAP) { atomicAdd(&bar[XB_TMO], 1u); break; } }
    }
    nloc = mine > 0u ? mine : 1u; nx = cnt > 0u ? cnt : 1u;
}

__device__ __forceinline__ void xcd_barrier(const XcdBarrier& b) {
    asm volatile("s_waitcnt vmcnt(0)" ::: "memory");
    __syncthreads();
    if (threadIdx.x == 0) {
        unsigned* bar = b.bar;
        __builtin_amdgcn_s_waitcnt(0);
        unsigned nloc = b.st[0], nx = b.st[1];
        if (nloc == 0u) { xcd_barrier_complete(bar, b.x, nloc, nx); b.st[0] = nloc; b.st[1] = nx; }
        const unsigned old = xb_add(&bar[XB_XSUB(b.x)], 1u);
        const unsigned gen = old / nloc;
        if (old + 1u == (gen + 1u) * nloc) {
            __builtin_amdgcn_fence(__ATOMIC_RELEASE, "agent");
            asm volatile("s_waitcnt vmcnt(0)" ::: "memory");
            const unsigned og = xb_add(&bar[XB_TOP], 1u);
            const unsigned tg = og / nx;
            if (og + 1u == (tg + 1u) * nx) xb_add(&bar[XB_TOPGEN], 1u);
            else XB_SPIN(xb_ld(&bar[XB_TOPGEN]) == tg, bar);
            __builtin_amdgcn_fence(__ATOMIC_ACQUIRE, "agent");
            xb_add(&bar[XB_XGEN(b.x)], 1u);
            asm volatile("s_waitcnt vmcnt(0)" ::: "memory");
        } else {
            XB_SPIN(xb_ld(&bar[XB_XGEN(b.x)]) == gen, bar);
            __builtin_amdgcn_fence(__ATOMIC_ACQUIRE, "agent");
            asm volatile("s_waitcnt vmcnt(0)" ::: "memory");
        }
    }
    __syncthreads();
}
__device__ __forceinline__ void p_tables(const Ctx& C0) { const Ctx C = fresh(C0);
    unsigned char* ws = C.ws;
    const float *qn_a = inp(C, I_QNA), *kn_a = inp(C, I_KNA), *qn_b = inp(C, I_QNB), *kn_b = inp(C, I_KNB);
    f32x2v* ropeA = (f32x2v*)(ws + WS_TAB + TAB_ROPEA); f32x2v* rowt = (f32x2v*)(ws + WS_TAB + TAB_ROW); f32x2v* colt = (f32x2v*)(ws + WS_TAB + TAB_COL);
    for (int i = C.bid + C.G * C.tid; i < 2048 * 8 + 32 * 16 + 64 * 16; i += C.G * NTHR) {
        if (i < 2048 * 8) { const int pos = i >> 3, f = i & 7; const double a = (double)pos * pow(500000.0, -(double)f / 8.0); ropeA[i] = (f32x2v){(float)cos(a), (float)sin(a)}; }
        else if (i < 2048 * 8 + 512) { const int j = i - 2048 * 8, pos = j >> 4, f = j & 15; const double a = (double)pos * pow(10000.0, -(double)f / 16.0); rowt[j] = (f32x2v){(float)cos(a), (float)sin(a)}; }
        else { const int j = i - 2048 * 8 - 512, pos = j >> 4, f = j & 15; const double a = (double)pos * pow(10000.0, -(double)f / 16.0); colt[j] = (f32x2v){(float)cos(a), (float)sin(a)}; }
    }
    if (C.bid == C.G - 1 && C.tid == NTHR - 1) {
        float ma = 0.f;
        for (int g = 0; g < 3; ++g) { float q = 0.f, k = 0.f; for (int d = 0; d < 64; ++d) { q = fmaxf(q, fabsf(qn_a[g * 64 + d])); k = fmaxf(k, fabsf(kn_a[g * 64 + d])); } ma = fmaxf(ma, q * k); }
        float q = 0.f, k = 0.f; for (int d = 0; d < 64; ++d) { q = fmaxf(q, fabsf(qn_b[d])); k = fmaxf(k, fabsf(kn_b[d])); }
        float* sh = (float*)(ws + WS_TAB + TAB_SHIFT); sh[0] = 64.f * ma * C2 * 1.02f; sh[1] = 64.f * q * k * C2 * 1.02f;
    }
}

template <int MAP, bool F8 = (MAP == 1)> __device__ __forceinline__ void transpose_item(const float* W, int N, int nblk, bf16* WT, int ldk, int row_off, LAS float* scr, int item, int lane) {
    const int kb = item / nblk, nb = item % nblk, k0 = 64 * kb, n0 = 32 * nb;
    if (MAP == 1 || true) {
        if (MAP == 1) {
            const int cm = colmap_in(n0 + (lane & 31));
#pragma unroll
            for (int i = 0; i < 32; ++i) { const int kk = 2 * i + (lane >> 5); scr[kk * 33 + (lane & 31)] = __builtin_nontemporal_load(W + (size_t)(k0 + kk) * N + cm); }
        } else {
            const int c0 = MAP == 2 ? colmap_gu(n0) : n0, n4 = (lane & 7) * 4; f32x4 v[8];
#pragma unroll
            for (int i = 0; i < 8; ++i) v[i] = __builtin_nontemporal_load((const f32x4*)(W + (size_t)(k0 + 8 * i + (lane >> 3)) * N + c0 + n4));
#pragma unroll
            for (int i = 0; i < 8; ++i) { LAS float* d = scr + (8 * i + (lane >> 3)) * 33 + n4; d[0] = v[i].x; d[1] = v[i].y; d[2] = v[i].z; d[3] = v[i].w; }
        }
    }
    asm volatile("s_waitcnt lgkmcnt(0)" ::: "memory");
    const int c = lane & 7;
#pragma unroll
    for (int j = 0; j < 4; ++j) { const int n = (lane >> 3) + 8 * j; const LAS float* s = scr + (8 * c) * 33 + n;
        if (F8) { typedef unsigned u32x2t __attribute__((ext_vector_type(2)));
            const u32x2t o8 = {pk4_fp8(s[0 * 33] * S_W, s[1 * 33] * S_W, s[2 * 33] * S_W, s[3 * 33] * S_W), pk4_fp8(s[4 * 33] * S_W, s[5 * 33] * S_W, s[6 * 33] * S_W, s[7 * 33] * S_W)};
            *(u32x2t*)((unsigned char*)WT + (size_t)(row_off + n0 + n) * ldk + k0 + 8 * c) = o8; continue; }
        u32x4 o; o.x = pk2(s[0 * 33], s[1 * 33]); o.y = pk2(s[2 * 33], s[3 * 33]); o.z = pk2(s[4 * 33], s[5 * 33]); o.w = pk2(s[6 * 33], s[7 * 33]);
        *(u32x4*)(WT + (size_t)(row_off + n0 + n) * ldk + k0 + 8 * c) = o; }
    asm volatile("s_waitcnt lgkmcnt(0)" ::: "memory");
}
__device__ __forceinline__ void rms_row_to_bf16(const float* xrow, const float* g, bf16* orow, int lane) {
    const f32x4* xr = (const f32x4*)xrow + lane; const f32x4* gr = (const f32x4*)g + lane;
    f32x4 v[4]; float s = 0.f;
#pragma unroll
    for (int j = 0; j < 4; ++j) { v[j] = __builtin_nontemporal_load(xr + 64 * j); s += (v[j].x * v[j].x + v[j].y * v[j].y) + (v[j].z * v[j].z + v[j].w * v[j].w); }
    const float rstd = S_H / sqrtf(wave_sum(s) * (1.f / 1024.f) + EPS);
    unsigned* o4 = (unsigned*)orow + lane;
#pragma unroll
    for (int j = 0; j < 4; ++j) { const f32x4 gg = gr[64 * j]; o4[64 * j] = pk4_fp8(v[j].x * rstd * gg.x, v[j].y * rstd * gg.y, v[j].z * rstd * gg.z, v[j].w * rstd * gg.w); }
}
__device__ __forceinline__ void p_prep(const Ctx& C0) { const Ctx C = fresh(C0);
    LAS float* scr = (LAS float*)(C.lds + C.wave * 16384);
    const int gw = C.bid * NWAVES + C.wave, NGW = C.G * NWAVES, lane = C.lane; unsigned char* ws = C.ws;
    constexpr int I_IN = 16 * (NIN / 32), I_PA = 8 * 32, I_OUT = 16 * 32, I_R = 16;
    constexpr int NITEMS = I_R + I_IN + 2 * I_PA + I_OUT;
    for (int it = gw; it < NITEMS; it += NGW) {
        int r = it;
        if (r < I_R) { transpose_item<0>(inp(C, I_WR), 32, 1, (bf16*)(ws + WS_WRT), 1024, 0, scr, r, lane); continue; } r -= I_R;
        if (r < I_IN) { transpose_item<1>(inp(C, I_WIN), NIN, NIN / 32, (bf16*)(ws + WS_WIN), 1024, 0, scr, r, lane); continue; } r -= I_IN;
        if (r < I_PA) { transpose_item<0, true>(inp(C, I_WPA), 1024, 32, (bf16*)(ws + WS_WPA), 512, 0, scr, r, lane); continue; } r -= I_PA;
        if (r < I_PA) { transpose_item<0, true>(inp(C, I_WPB), 1024, 32, (bf16*)(ws + WS_WPB), 512, 0, scr, r, lane); continue; } r -= I_PA;
        transpose_item<0, true>(inp(C, I_WOUT), 1024, 32, (bf16*)(ws + WS_WOUT), 1024, 0, scr, r, lane);
    }
    for (int m = gw; m < TOK; m += NGW) rms_row_to_bf16(inp(C, I_X) + (size_t)m * DM, inp(C, I_GMIX), (bf16*)(ws + WS_XN + (size_t)m * DM), lane);
}
constexpr int QN_GU = NEXP * 16 * 64, QN_D = NEXP * 16 * 32;
template <int WHICH> __device__ __forceinline__ void cq_load(f32x4 (&v)[8], const float* Wb, int it, int lane) {
    constexpr int N = WHICH == 0 ? 2048 : 1024, NB = N / 32, IPE = 16 * NB;
    const int e = it / IPE, r = it % IPE, kb = r / NB, nb = r % NB, k0 = 64 * kb, n0 = 32 * nb, c0 = WHICH == 0 ? colmap_gu(n0) : n0;
    const float* W = Wb + (size_t)e * 1024 * N + (size_t)(k0 + (lane >> 3)) * N + c0 + (lane & 7) * 4;
#pragma unroll
    for (int i = 0; i < 8; ++i) v[i] = __builtin_nontemporal_load((const f32x4*)(W + (size_t)(8 * i) * N));
}
template <int WHICH, bool NTST = true> __device__ __forceinline__ void cq_finish(const f32x4 (&v)[8], bf16* WTb, int it, LAS float* scr, int lane) {
    constexpr int N = WHICH == 0 ? 2048 : 1024, NB = N / 32, IPE = 16 * NB;
    const int e = it / IPE, r = it % IPE, kb = r / NB, nb = r % NB, k0 = 64 * kb, n0 = 32 * nb;
#pragma unroll
    for (int i = 0; i < 8; ++i) { LAS float* d = scr + (8 * i + (lane >> 3)) * 33 + (lane & 7) * 4; d[0] = v[i].x; d[1] = v[i].y; d[2] = v[i].z; d[3] = v[i].w; }
    asm volatile("s_waitcnt lgkmcnt(0)" ::: "memory");
    const int c = lane & 7;
#pragma unroll
    for (int j = 0; j < 4; ++j) { const int n = (lane >> 3) + 8 * j; const LAS float* s = scr + (8 * c) * 33 + n; typedef unsigned u32x2q __attribute__((ext_vector_type(2)));
        const u32x2q o = {pk4_fp8(s[0 * 33] * S_W, s[1 * 33] * S_W, s[2 * 33] * S_W, s[3 * 33] * S_W), pk4_fp8(s[4 * 33] * S_W, s[5 * 33] * S_W, s[6 * 33] * S_W, s[7 * 33] * S_W)};
        u32x2q* dst = (u32x2q*)((unsigned char*)WTb + (size_t)(e * N + n0 + n) * 1024 + k0 + 8 * c); if constexpr (NTST) __builtin_nontemporal_store(o, dst); else *dst = o; }
    asm volatile("s_waitcnt lgkmcnt(0)" ::: "memory");
}
template <int WHICH, bool NTST = true> __device__ __forceinline__ void p_convq(const Ctx& C0, unsigned* stop_word, unsigned stop_at) { const Ctx C = fresh(C0);
    LAS float* scr = (LAS float*)(C.lds + C.wave * 16384); unsigned char* ws = C.ws; const int lane = C.lane;
    constexpr int QN = WHICH == 0 ? QN_GU : QN_D, SH = QN / 8, CH = 4;
    const int shard = C.bid & 7;
    unsigned* q = (unsigned*)(ws + WS_CTL) + (WHICH == 0 ? CW_QGU : CW_QD) + 64 * shard;
    const float* W = inp(C, WHICH == 0 ? I_WGU : I_WD); bf16* WT = (bf16*)(ws + (WHICH == 0 ? WS_WGU : WS_WD));
    for (;;) {
        unsigned it0 = 0, dn = 0;
        if (lane == 0) { it0 = atomicAdd(q, (unsigned)CH); if (stop_word) dn = __hip_atomic_load(stop_word, RLX_AGENT); }
        it0 = (unsigned)__builtin_amdgcn_readfirstlane((int)it0); dn = (unsigned)__builtin_amdgcn_readfirstlane((int)dn);
        if (it0 >= (unsigned)SH) break;
        const int base = shard * SH + (int)it0;
        f32x4 va[8], vb[8];
        cq_load<WHICH>(va, W, base, lane);
#pragma unroll
        for (int c = 0; c < CH; c += 2) {
            cq_load<WHICH>(vb, W, base + c + 1, lane); cq_finish<WHICH, NTST>(va, WT, base + c, scr, lane);
            if (c + 2 < CH) cq_load<WHICH>(va, W, base + c + 2, lane);
            cq_finish<WHICH, NTST>(vb, WT, base + c + 1, scr, lane); }
        if (stop_word && dn >= stop_at) break;
    }
}
__device__ __forceinline__ void p_router2(const Ctx& C0) { const Ctx C = fresh(C0);
    typedef short bf16x8 __attribute__((ext_vector_type(8))); typedef float f32x16 __attribute__((ext_vector_type(16)));
    unsigned char* ws = C.ws; const int tid = C.tid, lane = C.lane, wave = C.wave, r32 = lane & 31, hi = lane >> 5;
    const float* g = inp(C, I_GFFN); const float* b_r = inp(C, I_BR); const bf16* WRT = (const bf16*)(ws + WS_WRT);
    constexpr int RSB = 2064;
    LAS unsigned char* RH = C.lds; LAS float* PART = (LAS float*)(C.lds + 32 * RSB); LAS int* CN = (LAS int*)(C.lds + 32 * RSB + 8 * 32 * 33 * 4);
    const int rqs = C.bid & 7; unsigned* rq = (unsigned*)(ws + WS_CTL) + CW_RQ + 64 * rqs;
    for (;;) {
        if (tid == 0) CN[64] = (int)atomicAdd(rq, 1u);
        if (tid < 32) CN[tid] = 0;
        __syncthreads();
        const int bl = CN[64]; if (bl >= TOK / 32 / 8) break;
        const int blk = rqs * (TOK / 32 / 8) + bl;
        const int row0 = blk * 32;
#pragma unroll
        for (int q = 0; q < 4; ++q) { const int rl = wave * 4 + q, row = row0 + rl;
            const bf16* xr = (const bf16*)(ws + WS_X1) + (size_t)row * DM + 8 * lane;
            float v[2][8]; float s = 0.f;
#pragma unroll
            for (int hh = 0; hh < 2; ++hh) { const u32x4 w = *(const u32x4*)(xr + 512 * hh);
                v[hh][0] = __uint_as_float(w.x << 16); v[hh][1] = __uint_as_float(w.x & 0xffff0000u); v[hh][2] = __uint_as_float(w.y << 16); v[hh][3] = __uint_as_float(w.y & 0xffff0000u);
                v[hh][4] = __uint_as_float(w.z << 16); v[hh][5] = __uint_as_float(w.z & 0xffff0000u); v[hh][6] = __uint_as_float(w.w << 16); v[hh][7] = __uint_as_float(w.w & 0xffff0000u);
#pragma unroll
                for (int i = 0; i < 8; ++i) s += v[hh][i] * v[hh][i]; }
            const float rstd = 1.f / sqrtf(wave_sum(s) * (1.f / 1024.f) + EPS);
            unsigned char* o8 = ws + WS_H2 + (size_t)row * DM + 8 * lane;
#pragma unroll
            for (int hh = 0; hh < 2; ++hh) { const f32x4 g0 = *(const f32x4*)(g + 512 * hh + 8 * lane), g1 = *(const f32x4*)(g + 512 * hh + 8 * lane + 4);
                u32x4 w; w.x = pk2(v[hh][0] * rstd * g0.x, v[hh][1] * rstd * g0.y); w.y = pk2(v[hh][2] * rstd * g0.z, v[hh][3] * rstd * g0.w); w.z = pk2(v[hh][4] * rstd * g1.x, v[hh][5] * rstd * g1.y); w.w = pk2(v[hh][6] * rstd * g1.z, v[hh][7] * rstd * g1.w);
                { typedef unsigned u32x2h __attribute__((ext_vector_type(2))); const float sc = rstd * S_H;
                  const u32x2h w8 = {pk4_fp8(v[hh][0] * sc * g0.x, v[hh][1] * sc * g0.y, v[hh][2] * sc * g0.z, v[hh][3] * sc * g0.w), pk4_fp8(v[hh][4] * sc * g1.x, v[hh][5] * sc * g1.y, v[hh][6] * sc * g1.z, v[hh][7] * sc * g1.w)};
                  *(u32x2h*)(o8 + 512 * hh) = w8; }
                *(LAS u32x4*)(RH + rl * RSB + (512 * hh + 8 * lane) * 2) = w; } }
        __syncthreads();
        { f32x16 acc = {};
#pragma unroll
          for (int s = 0; s < 8; ++s) { const int k0 = 128 * wave + 16 * s + 8 * hi;
              const bf16x8 a = *(const bf16x8*)(WRT + (size_t)r32 * 1024 + k0); const bf16x8 b = *(const LAS bf16x8*)(RH + r32 * RSB + k0 * 2);
              acc = __builtin_amdgcn_mfma_f32_32x32x16_bf16(a, b, acc, 0, 0, 0); }
#pragma unroll
          for (int i = 0; i < 16; ++i) PART[(wave * 32 + r32) * 33 + (i & 3) + 8 * (i >> 2) + 4 * hi] = acc[i]; }
        __syncthreads();
        int my_e = 0, my_pos = 0; float my_g = 0.f; const int rr = tid >> 3, sub = tid & 7;
        if (tid < 256) {
            unsigned key[4];
#pragma unroll
            for (int c = 0; c < 4; ++c) { const int e = sub * 4 + c; float a = b_r[e];
#pragma unroll
                for (int w = 0; w < 8; ++w) a += PART[(w * 32 + rr) * 33 + e];
                const unsigned u = __float_as_uint(a); key[c] = (((u & 0x80000000u) ? ~u : (u | 0x80000000u)) & ~31u) | (unsigned)(31 - e); }
            unsigned top[4];
#pragma unroll
            for (int k = 0; k < 4; ++k) { unsigned m = key[0] > key[1] ? key[0] : key[1]; const unsigned m2 = key[2] > key[3] ? key[2] : key[3]; m = m > m2 ? m : m2;
#pragma unroll
                for (int o = 1; o < 8; o <<= 1) { const unsigned x = (unsigned)__shfl_xor((int)m, o); m = m > x ? m : x; }
                top[k] = m;
#pragma unroll
                for (int c = 0; c < 4; ++c) if (key[c] == m) key[c] = 0u; }
            float tv[4];
#pragma unroll
            for (int k = 0; k < 4; ++k) { const unsigned kk = top[k] & ~31u; tv[k] = __uint_as_float((kk & 0x80000000u) ? (kk & 0x7fffffffu) : ~kk); }
            const float e1 = __expf(tv[1] - tv[0]), e2 = __expf(tv[2] - tv[0]), e3 = __expf(tv[3] - tv[0]); const float rs = 1.f / (1.f + e1 + e2 + e3);
            if (sub < 4) { const unsigned t = sub == 0 ? top[0] : sub == 1 ? top[1] : sub == 2 ? top[2] : top[3]; my_e = 31 - (int)(t & 31u);
                my_g = (sub == 0 ? 1.f : sub == 1 ? e1 : sub == 2 ? e2 : e3) * rs;
                my_pos = __hip_atomic_fetch_add(CN + my_e, 1, __ATOMIC_RELAXED, __HIP_MEMORY_SCOPE_WORKGROUP); }
        }
        __syncthreads();
        if (tid < 32) { const int c = CN[tid]; CN[32 + tid] = c ? (int)atomicAdd((unsigned*)(ws + WS_CTL) + CW_CNT + tid, (unsigned)c) : 0; }
        __syncthreads();
        if (tid < 256 && sub < 4) { const int row = row0 + rr, slot = CN[32 + my_e] + my_pos;
            int* list = (int*)(ws + WS_LIST) + ((size_t)my_e * LISTCAP + slot) * 2; list[0] = row; list[1] = __float_as_int(my_g);
            int* pair = (int*)(ws + WS_PAIR) + ((size_t)row * 4 + sub) * 2; pair[0] = my_e; pair[1] = slot; }
        __syncthreads();
    }
}
__device__ __forceinline__ void p_meta2(const Ctx& C0) { const Ctx C = fresh(C0);
    LAS int* meta = (LAS int*)(C.lds + META_OFF); LAS int* tokTab = (LAS int*)(C.lds + TOKTAB_OFF);
    if (C.tid < 64) {
        const int cnt = C.tid < NEXP ? (int)__hip_atomic_load((unsigned*)(C.ws + WS_CTL) + CW_CNT + (C.tid & 31), RLX_AGENT) : 0; const int nt = (cnt + 255) >> 8; int inc = nt;
#pragma unroll
        for (int o = 1; o < 32; o <<= 1) { const int v = __shfl_up(inc, o); if ((C.tid & 63) >= o) inc += v; }
        if (C.tid < NEXP) { meta[MT_CNT + C.tid] = cnt; meta[MT_BASE + C.tid] = inc - nt; }
        if (C.tid == NEXP - 1) { meta[MT_BASE + NEXP] = inc; meta[MT_NT] = inc; } }
    __syncthreads();
    if (C.tid < MAXTILES) { int e = 0; for (int q = 1; q < NEXP; ++q) if (meta[MT_BASE + q] <= C.tid) e = q; meta[MT_TILE + C.tid] = e; }
    __syncthreads();
    const int nunits = meta[MT_NT] * 8, G7 = gemm_grid(nunits, C.G); const int* list = (const int*)(C.ws + WS_LIST);
    if (C.bid < G7) for (int x = C.tid; x < MAXUNITS_GU * 256; x += NTHR) { const int i = x >> 8, r = x & 255; const long L = (long)i * G7 + xcd_rank(C.bid, G7); int tok = 0;
        if (L < nunits) { const int t = (int)(L >> 3), e = meta[MT_TILE + t], slot = 256 * (t - meta[MT_BASE + e]) + r; if (slot < meta[MT_CNT + e]) tok = list[((size_t)e * LISTCAP + slot) * 2]; }
        tokTab[x] = tok; }
    __syncthreads();
}
__device__ __forceinline__ void p_combine(const Ctx& C0) { const Ctx C = fresh(C0);
    typedef unsigned u32x2c __attribute__((ext_vector_type(2)));
    unsigned char* ws = C.ws; const LAS int* meta = (const LAS int*)(C.lds + META_OFF); const int lane = C.lane;
    const unsigned char* Y = ws + WS_Y; const int step = C.G * NWAVES * 2;
    const int row2 = (pg8::moe_split_full(meta[MT_NT] * 4, C.G) >> 2) << 8; const unsigned char* Y2 = ws + WS_Y2 - (size_t)row2 * DM;
    int t0 = (C.bid * NWAVES + C.wave) * 2;
    u32x4 pc[4], pn[4];
    if (t0 < TOK) { const u32x4* pp = (const u32x4*)((const int*)(ws + WS_PAIR) + (size_t)t0 * 8);
#pragma unroll
        for (int q = 0; q < 4; ++q) pc[q] = pp[q]; }
    for (; t0 < TOK; t0 += step) {
        u32x4 a[2][2]; u32x2c y[2][4][2], y2[2][4][2];
#pragma unroll
        for (int r = 0; r < 2; ++r) { const int t = t0 + r;
            const bf16* xp = (const bf16*)(ws + WS_X1) + (size_t)t * DM + 8 * lane;
            a[r][0] = __builtin_nontemporal_load((const u32x4*)xp); a[r][1] = __builtin_nontemporal_load((const u32x4*)(xp + 512));
#pragma unroll
            for (int k = 0; k < 4; ++k) { const u32x4 w = pc[2 * r + (k >> 1)]; const int e = __builtin_amdgcn_readfirstlane((int)((k & 1) ? w.z : w.x)), slot = __builtin_amdgcn_readfirstlane((int)((k & 1) ? w.w : w.y));
                const size_t row = (size_t)256 * meta[MT_BASE + e] + slot;
                const unsigned char* yp = Y + row * DM + 8 * lane; y[r][k][0] = __builtin_nontemporal_load((const u32x2c*)yp); y[r][k][1] = __builtin_nontemporal_load((const u32x2c*)(yp + 512));
                y2[r][k][0] = y2[r][k][1] = (u32x2c){0u, 0u};
                if (row >= (size_t)row2) { const unsigned char* zp = Y2 + row * DM + 8 * lane; y2[r][k][0] = __builtin_nontemporal_load((const u32x2c*)zp); y2[r][k][1] = __builtin_nontemporal_load((const u32x2c*)(zp + 512)); } } }
        if (t0 + step < TOK) { const u32x4* pp = (const u32x4*)((const int*)(ws + WS_PAIR) + (size_t)(t0 + step) * 8);
#pragma unroll
            for (int q = 0; q < 4; ++q) pn[q] = pp[q]; }
#pragma unroll
        for (int r = 0; r < 2; ++r) { float* op = C.out + (size_t)(t0 + r) * DM + 8 * lane;
#pragma unroll
            for (int h = 0; h < 2; ++h) { const u32x4 xw = a[r][h]; f32x4 lo = {0.f, 0.f, 0.f, 0.f}, hi = {0.f, 0.f, 0.f, 0.f};
#pragma unroll
                for (int k = 0; k < 4; ++k) { const u32x2c w = y[r][k][h], w2 = y2[r][k][h];
                    lo = add4_fp8(lo, w2.x); hi = add4_fp8(hi, w2.y); lo = add4_fp8(lo, w.x); hi = add4_fp8(hi, w.y); }
                constexpr float cy = 1.0f / S_Y;
                lo.x = lo.x * cy + __uint_as_float(xw.x << 16); lo.y = lo.y * cy + __uint_as_float(xw.x & 0xffff0000u); lo.z = lo.z * cy + __uint_as_float(xw.y << 16); lo.w = lo.w * cy + __uint_as_float(xw.y & 0xffff0000u);
                hi.x = hi.x * cy + __uint_as_float(xw.z << 16); hi.y = hi.y * cy + __uint_as_float(xw.z & 0xffff0000u); hi.z = hi.z * cy + __uint_as_float(xw.w << 16); hi.w = hi.w * cy + __uint_as_float(xw.w & 0xffff0000u);
                __builtin_nontemporal_store(lo, (f32x4*)(op + h * 512)); __builtin_nontemporal_store(hi, (f32x4*)(op + h * 512 + 4)); } }
#pragma unroll
        for (int q = 0; q < 4; ++q) pc[q] = pn[q];
    }
}
namespace attn_a {
typedef short bf16x8 __attribute__((ext_vector_type(8)));
typedef short s16x4 __attribute__((ext_vector_type(4)));
typedef float f32x16 __attribute__((ext_vector_type(16)));
typedef float f32x2_t __attribute__((ext_vector_type(2))); typedef __bf16 bf16x2_t __attribute__((ext_vector_type(2)));
constexpr int RS = 160, RSK = 144;
constexpr int A_IMG = 0, A_ROW = 132, A_VST = 512 * A_ROW, A_WST = 32 * (RS + RSK), A_KOFF = 32 * RS, A_BYTES = A_VST + 8 * A_WST;
static_assert(A_BYTES <= LDSCTL_OFF, "mixer A LDS");
__device__ __forceinline__ unsigned cvtpk(float lo, float hi) { f32x2_t v = {lo, hi}; bf16x2_t b = __builtin_convertvector(v, bf16x2_t); return __builtin_bit_cast(unsigned, b); }
__device__ __forceinline__ s16x4 vtr(const LAS unsigned char* p) { typedef short v4i16_t __attribute__((ext_vector_type(4))); return __builtin_bit_cast(s16x4, __builtin_amdgcn_ds_read_tr16_b64_v4i16((LAS v4i16_t*)p)); }
__device__ __forceinline__ int crow(int r, int hi) { return (r & 3) + 8 * (r >> 2) + 4 * hi; }

struct ItemP { int g, dil, L, m0, r, nq, pmul, padd, hh; };
__device__ __forceinline__ ItemP item_params(int it, int span, int h) { ItemP P; P.nq = 32;
    if (it < 16) { P.g = 0; P.dil = 1; P.L = 2048; P.m0 = 512 * span + 32 * it; P.r = 0; P.pmul = 1; P.padd = 32 * it; }
    else if (it < 32) { const int x = it - 16; P.g = 1; P.dil = 4; P.L = 512; P.r = x >> 2; P.m0 = 128 * span + 32 * (x & 3); P.pmul = 4; P.padd = 128 * (x & 3) + P.r; }
    else { P.g = 2; P.dil = 16; P.L = 128; P.r = it - 32; P.m0 = 32 * span; P.pmul = 16; P.padd = P.r; }
    P.hh = h; return P; }
__device__ __forceinline__ long slab_row(const ItemP& P, int tokbase, int m) { return ((long)((tokbase >> 11) * 24 + P.g * 8 + P.hh) * 2048 + P.r * P.L + m) * 64; }
typedef unsigned u32x2k __attribute__((ext_vector_type(2)));
template <bool DOK, bool DOV> __device__ __forceinline__ void load_tile(const ItemP& P, int k, int tokbase, const bf16* KA, const bf16* VA, int lane, u32x2k (&kfn)[4], u32x2k (&vrn)[4]) {
    const int mk0 = P.m0 - 64 + 32 * k;
    if (mk0 < 0 || mk0 >= P.L) {
#pragma unroll
        for (int c = 0; c < 4; ++c) { if (DOK) kfn[c] = (u32x2k){0u, 0u}; if (DOV) vrn[c] = (u32x2k){0u, 0u}; }
        return; }
    const long sb = slab_row(P, tokbase, mk0) * 2;
    const unsigned voff = (unsigned)lane * 16u;
#pragma unroll
    for (int c = 0; c < 4; ++c) { const long so = sb + 1024 * c;
        if (DOK) kfn[c] = *(const u32x2k*)((const char*)KA + (so >> 1) + (voff >> 1)); if (DOV) vrn[c] = *(const u32x2k*)((const char*)VA + (so >> 1) + (voff >> 1)); }
}
__device__ __forceinline__ void preload(const ItemP& P, int tokbase, const bf16* QA, const bf16* KA, const bf16* VA, int lane, long (&qf)[4], u32x2k (&kfn)[4]) {
    u32x2k vrn[4];
    const unsigned char* qp = (const unsigned char*)QA + slab_row(P, tokbase, P.m0) + lane * 8;
#pragma unroll
    for (int d0 = 0; d0 < 4; ++d0) qf[d0] = *(const long*)(qp + d0 * 512);
    load_tile<true, false>(P, 0, tokbase, KA, VA, lane, kfn, vrn);
}
template <bool G2> __device__ __forceinline__ void item(const Ctx& C, int ii, int b, int h, int span, int tokbase, float M0, const bf16* QA, const bf16* KA, const bf16* VA, LAS unsigned char* IMG, LAS unsigned char* vst, int wr_off, int tr_off, long (&qf)[4], u32x2k (&kfn)[4]) {
    int lane_ = C.lane; asm volatile("" : "+v"(lane_));
    const int lane = lane_, wave = C.wave, r32 = lane & 31, hi = lane >> 5;

            const ItemP P = item_params(ii * 8 + wave, span, h);
            const int dil = P.dil, L = P.L, m0 = P.m0, r = P.r, pmul = P.pmul, padd = P.padd; (void)dil; (void)r;
            u32x2k kb[2][4], vb[2][4];
#pragma unroll
            for (int d0 = 0; d0 < 4; ++d0) kb[0][d0] = kfn[d0];
            load_tile<false, true>(P, 0, tokbase, KA, VA, lane, kfn, vb[0]);
            load_tile<true, true>(P, 1, tokbase, KA, VA, lane, kb[1], vb[1]);
            f32x16 o0 = {}, o1 = {}; float l = 0.f;
            const LAS unsigned char* tb = vst + tr_off;
#define A_IN(k) ((m0 - 64 + 32 * (k)) >= 0 && (m0 - 64 + 32 * (k)) < L)
#define A_W2(w_) ({ const f32x2y lo_ = __builtin_amdgcn_cvt_pk_f32_fp8((int)(w_), false), hi_ = __builtin_amdgcn_cvt_pk_f32_fp8((int)(w_), true); u32x2k r_ = {cvtpk(lo_.x, lo_.y), cvtpk(hi_.x, hi_.y)}; r_; })
#define A_STAGE_V(buf) do { _Pragma("unroll") for (int c = 0; c < 4; ++c) { const u32x2k a_ = A_W2(vb[buf][c].x), b_ = A_W2(vb[buf][c].y); *(LAS u32x4*)(vst + (8 * c + (lane >> 3)) * RS + (lane & 7) * 16) = (u32x4){a_.x, a_.y, b_.x, b_.y}; } } while (0)
#define A_FRAG_K(buf) do { _Pragma("unroll") for (int d0 = 0; d0 < 4; ++d0) kf[d0] = __builtin_bit_cast(long, kb[buf][d0]); } while (0)
#define A_READ_K() do { _Pragma("unroll") for (int d0 = 0; d0 < 4; ++d0) kf[d0] = *(const LAS bf16x8*)(vst + A_KOFF + r32 * RSK + 32 * d0 + 16 * hi); } while (0)
#define A_QK(dst, init) do { _Pragma("unroll") for (int i = 0; i < 16; ++i) dst[i] = (init); _Pragma("unroll") for (int d0 = 0; d0 < 4; ++d0) dst = __builtin_amdgcn_mfma_f32_32x32x16_fp8_fp8(kf[d0], qf[d0], dst, 0, 0, 0); } while (0)
#define A_VF(dblk, s) ({ const s16x4 lo_ = vtr(tb + (16 * (s)) * RS + (dblk) * 64), hi_ = vtr(tb + (16 * (s) + 8) * RS + (dblk) * 64); (bf16x8){lo_[0], lo_[1], lo_[2], lo_[3], hi_[0], hi_[1], hi_[2], hi_[3]}; })
            long kf[4]; f32x16 sc[2];
            A_FRAG_K(0); A_QK(sc[0], A_IN(0) ? -M0 : -1e30f); A_STAGE_V(0);
#pragma unroll
            for (int k = 0; k < 5; ++k) {
                if (k < 3) load_tile<true, true>(P, k + 2, tokbase, KA, VA, lane, kb[k & 1], vb[k & 1]);
                bf16x8 pa0, pa1;
                { f32x16& acc = sc[k & 1]; float p[16]; float ls = 0.f;
#pragma unroll
                    for (int i = 0; i < 16; ++i) { const int kr = crow(i, hi); bool valid = true;
                        if (k == 0) valid = kr >= r32;
                        if (k == 4) valid = kr <= r32;
                        const float ex = __builtin_amdgcn_exp2f(acc[i]);
                        p[i] = (k == 0 || k == 4) ? (valid ? ex : 0.f) : ex; ls += p[i]; }
                    l += ls;
                    u32x4 pw0, pw1;
                    pw0.x = cvtpk(p[0], p[1]); pw0.y = cvtpk(p[2], p[3]); pw0.z = cvtpk(p[4], p[5]); pw0.w = cvtpk(p[6], p[7]);
                    pw1.x = cvtpk(p[8], p[9]); pw1.y = cvtpk(p[10], p[11]); pw1.z = cvtpk(p[12], p[13]); pw1.w = cvtpk(p[14], p[15]);
                    pa0 = __builtin_bit_cast(bf16x8, pw0); pa1 = __builtin_bit_cast(bf16x8, pw1); }
                const bf16x8 v00 = A_VF(0, 0), v01 = A_VF(0, 1), v10 = A_VF(1, 0), v11 = A_VF(1, 1);
                if (k < 4) { A_FRAG_K((k + 1) & 1); A_QK(sc[(k + 1) & 1], A_IN(k + 1) ? -M0 : -1e30f); }
                o0 = __builtin_amdgcn_mfma_f32_32x32x16_bf16(v00, pa0, o0, 0, 0, 0); o0 = __builtin_amdgcn_mfma_f32_32x32x16_bf16(v01, pa1, o0, 0, 0, 0);
                o1 = __builtin_amdgcn_mfma_f32_32x32x16_bf16(v10, pa0, o1, 0, 0, 0); o1 = __builtin_amdgcn_mfma_f32_32x32x16_bf16(v11, pa1, o1, 0, 0, 0);
                if (k < 4) A_STAGE_V((k + 1) & 1);
            }
#undef A_IN
#undef A_STAGE_V
#undef A_W2
#undef A_READ_K
#undef A_FRAG_K
#undef A_QK
#undef A_VF
            if (ii < 5) { const ItemP PN = item_params((ii + 1) * 8 + wave, span, h); preload(PN, tokbase, QA, KA, VA, lane, qf, kfn); }
            l += __shfl_xor(l, 32);
            { LAS unsigned char* rowp = IMG + (r32 * pmul + padd) * A_ROW + 8 * hi;
              if (ii < 2) {
#pragma unroll
                for (int gq = 0; gq < 4; ++gq) { LAS unsigned* d0 = (LAS unsigned*)(rowp + 16 * gq); LAS unsigned* d1 = (LAS unsigned*)(rowp + 64 + 16 * gq);
                    d0[0] = cvtpk(o0[4 * gq], o0[4 * gq + 1]); d0[1] = cvtpk(o0[4 * gq + 2], o0[4 * gq + 3]); d1[0] = cvtpk(o1[4 * gq], o1[4 * gq + 1]); d1[1] = cvtpk(o1[4 * gq + 2], o1[4 * gq + 3]); }
                if (hi == 0) *(LAS float*)(rowp + 128) = l;
              } else {
#pragma unroll
                for (int gq = 0; gq < 4; ++gq) { LAS unsigned* d0 = (LAS unsigned*)(rowp + 16 * gq); LAS unsigned* d1 = (LAS unsigned*)(rowp + 64 + 16 * gq);
                    const unsigned a0 = d0[0], a1 = d0[1], b0 = d1[0], b1 = d1[1];
                    d0[0] = cvtpk(o0[4 * gq] + __uint_as_float(a0 << 16), o0[4 * gq + 1] + __uint_as_float(a0 & 0xffff0000u)); d0[1] = cvtpk(o0[4 * gq + 2] + __uint_as_float(a1 << 16), o0[4 * gq + 3] + __uint_as_float(a1 & 0xffff0000u));
                    d1[0] = cvtpk(o1[4 * gq] + __uint_as_float(b0 << 16), o1[4 * gq + 1] + __uint_as_float(b0 & 0xffff0000u)); d1[1] = cvtpk(o1[4 * gq + 2] + __uint_as_float(b1 << 16), o1[4 * gq + 3] + __uint_as_float(b1 & 0xffff0000u)); }
                if (hi == 0) *(LAS float*)(rowp + 128) += l;
              } }
        }
__device__ __forceinline__ void phase(const Ctx& C0) { const Ctx C = fresh(C0);
    unsigned char* ws = C.ws; const int tid = C.tid, lane = C.lane, wave = C.wave, hi = lane >> 5;
    const bf16* QA = (const bf16*)(ws + WS_QA); const bf16* KA = (const bf16*)(ws + WS_KA); const bf16* VA = (const bf16*)(ws + WS_VA);
    const float M0 = ((const float*)(ws + WS_TAB + TAB_SHIFT))[0];
    LAS unsigned char* IMG = C.lds + A_IMG; LAS unsigned char* vst = C.lds + A_VST + wave * A_WST;
    const int vcu = (C.G % 8 == 0) ? (C.bid % 8) * (C.G / 8) + C.bid / 8 : C.bid, nper = (256 + C.G - 1) / C.G;
    const int wr_off = 0;
    const int tr_off = (4 * hi + ((lane & 15) >> 2)) * RS + (((lane >> 4) & 1) * 16 + (lane & 3) * 4) * 2;
    for (int ui = 0; ui < nper; ++ui) {
        const int U = vcu * nper + ui; if (U >= 256) break;
        const int b = U >> 5, h = (U >> 2) & 7, span = U & 3, tokbase = b * SEQ;
        long qf[4]; u32x2k kfn[4];
        { const ItemP P0 = item_params(wave, span, h); preload(P0, tokbase, QA, KA, VA, lane, qf, kfn); }
#pragma unroll 1
        for (int ii = 0; ii < 6; ++ii) {
            item<false>(C, ii, b, h, span, tokbase, M0, QA, KA, VA, IMG, vst, wr_off, tr_off, qf, kfn);
            if (ii == 1 || ii == 3) __syncthreads();
        }
        __syncthreads();
        unsigned char* OA = ws + WS_OA + (size_t)(tokbase + 512 * span) * 512 + h * 64;
        int tidn = tid; asm volatile("" : "+v"(tidn));
#pragma unroll
        for (int k = 0; k < 8; ++k) { const int item = tidn + NTHR * k, pos = item >> 3, ch = item & 7; const LAS unsigned* src = (const LAS unsigned*)(IMG + pos * A_ROW + 16 * ch); const float rl = 1.f / *(const LAS float*)(IMG + pos * A_ROW + 128);
            const unsigned s0 = src[0], s1 = src[1], s2 = src[2], s3 = src[3];
            typedef unsigned u32x2o __attribute__((ext_vector_type(2))); const float rs_ = rl * S_O;
            const u32x2o w = {pk4_fp8(__uint_as_float(s0 << 16) * rs_, __uint_as_float(s0 & 0xffff0000u) * rs_, __uint_as_float(s1 << 16) * rs_, __uint_as_float(s1 & 0xffff0000u) * rs_), pk4_fp8(__uint_as_float(s2 << 16) * rs_, __uint_as_float(s2 & 0xffff0000u) * rs_, __uint_as_float(s3 << 16) * rs_, __uint_as_float(s3 & 0xffff0000u) * rs_)};
            *(u32x2o*)((unsigned char*)OA + (size_t)pos * 512 + 8 * ch) = w; }
        __syncthreads();
    }
}
}
struct Args { const float* in[18]; float* out; unsigned char* ws; };
__global__ void __launch_bounds__(NTHR, 2) fwd(Args args) {
    extern __shared__ __attribute__((aligned(16))) unsigned char lds_raw[];
    Ctx C;
    C.out = args.out; C.ws = args.ws; C.lds = (LAS unsigned char*)lds_raw;
    C.tid = threadIdx.x; C.lane = C.tid & 63; C.wave = __builtin_amdgcn_readfirstlane(C.tid >> 6); C.G = gridDim.x; C.bid = blockIdx.x;
    unsigned char* ws = C.ws;
    for (int u = C.tid; u < (LDS_BYTES - LDSCTL_OFF) / 4; u += NTHR) ((LAS unsigned*)(C.lds + LDSCTL_OFF))[u] = 0u;
    __syncthreads();
    if (C.tid < 18) ((LAS unsigned long long*)(C.lds + PTR_OFF))[C.tid] = (unsigned long long)args.in[C.tid];
    __syncthreads();
    volatile LAS unsigned* MISC = (volatile LAS unsigned*)(C.lds + MISC_OFF);
    XcdBarrier bar = xcd_barrier_post((unsigned*)(ws + WS_CTL) + CW_BAR, MISC + 8);
    typedef pg8::bf16_t b16;
    PG8_LAS unsigned char* ring = (PG8_LAS unsigned char*)lds_raw;

    p_tables(C); p_prep(C);
    xcd_barrier(bar);
    { const int G1 = gemm_grid((TOK / 256) * (NIN / 256), C.G); unsigned* done1 = (unsigned*)(ws + WS_CTL) + CW_DONE1;
      if (C.bid < G1) { pg8::Gemm g{(const b16*)(ws + WS_XN), (const b16*)(ws + WS_WIN), TOK, NIN, DM / 2, 0};     pg8::StaticOrder S; S.init(TOK, NIN, G1, C.bid);
          pg8::EpiInProj E{C.lds, ws}; pg8::gemm_phase<pg8::EpiInProj, pg8::StaticOrder, true, true, false, true>(ring, g, S, E);
          if (C.tid == 0) __hip_atomic_fetch_add(done1, 1u, RLX_AGENT); }
      else p_convq<0>(C, done1, (unsigned)G1); }
    xcd_barrier(bar);
    attn_a::phase(C);
    { const attn_body::AttnTensors AT{(const attn_body::bf16*)(ws + WS_QB), (const attn_body::bf16*)(ws + WS_KB), (const attn_body::bf16*)(ws + WS_VB), (attn_body::bf16*)(ws + WS_OB)};
      const attn_body::StaticOrder S((int)C.G, (int)C.bid); const float M0B = ((const float*)(ws + WS_TAB + TAB_SHIFT))[1];
      attn_body::attn_phase<attn_body::StaticOrder>((char*)lds_raw, AT, S, M0B); }
    xcd_barrier(bar);
    { pg8::Gemm g{(const b16*)(ws + WS_OA), (const b16*)(ws + WS_WPA), TOK, DM, 256, 0};     pg8::StaticOrder S; S.init(TOK, DM, C.G, C.bid);
      pg8::EpiGate<0> E{(const b16*)(ws + WS_GATES), (b16*)(ws + WS_TMP), (b16*)(ws + WS_MRG)}; pg8::gemm_phase<pg8::EpiGate<0>, pg8::StaticOrder, true, true, false, true>(ring, g, S, E); }
    { pg8::Gemm g{(const b16*)(ws + WS_OB), (const b16*)(ws + WS_WPB), TOK, DM, 256, 0}; pg8::StaticOrder S; S.init(TOK, DM, C.G, C.bid);
      pg8::EpiGate<1> E{(const b16*)(ws + WS_GATES), (b16*)(ws + WS_TMP), (b16*)(ws + WS_MRG)}; pg8::gemm_phase<pg8::EpiGate<1>, pg8::StaticOrder, true, true, false, true>(ring, g, S, E); }
    xcd_barrier(bar);
    { pg8::Gemm g{(const b16*)(ws + WS_MRG), (const b16*)(ws + WS_WOUT), TOK, DM, DM / 2, 0};     pg8::StaticOrder S; S.init(TOK, DM, C.G, C.bid);
      pg8::EpiRes E{inp(C, I_X), (b16*)(ws + WS_X1), DM, 0}; pg8::gemm_phase<pg8::EpiRes, pg8::StaticOrder, true, true, false, true>(ring, g, S, E); }
    xcd_barrier(bar);
    if ((C.bid >> 3) & 1) { p_convq<0, false>(C, nullptr, 0u); __syncthreads(); p_router2(C); } else { p_router2(C); __syncthreads(); p_convq<0, false>(C, nullptr, 0u); }
    xcd_barrier(bar);
    p_meta2(C);
    const PG8_LAS int* meta = (const PG8_LAS int*)(C.lds + META_OFF);
    { const int G7 = gemm_grid(meta[MT_NT] * 8, C.G); unsigned* done7 = (unsigned*)(ws + WS_CTL) + CW_DONE7;
      if (C.bid < G7) { pg8::Gemm g{(const b16*)(ws + WS_H2), (const b16*)(ws + WS_WGU), TOK, NEXP * 2048, DM / 2, 0};     pg8::MoeOrder S{meta + MT_TILE, meta[MT_NT], 8, G7, xcd_rank(C.bid, G7)};
          pg8::EpiSwiglu E{inp(C, I_BGU), (b16*)(ws + WS_ACT)}; pg8::gemm_phase_gather<pg8::EpiSwiglu, pg8::MoeOrder, true>(ring, g, S, E, (const PG8_LAS int*)(C.lds + TOKTAB_OFF));
          if (C.tid == 0) __hip_atomic_fetch_add(done7, 1u, RLX_AGENT);
          p_convq<1, false>(C, nullptr, 0u); }
      else { p_convq<1>(C, done7, (unsigned)G7); p_convq<1, false>(C, nullptr, 0u); } }
    xcd_barrier(bar);
    { pg8::Gemm g{(const b16*)(ws + WS_ACT), (const b16*)(ws + WS_WD), MAXTILES * 256, NEXP * 1024, DFF / 2, 0}; pg8::MoeSplitOrder S{meta + MT_TILE, meta[MT_NT], 4, C.G, xcd_rank(C.bid, C.G)};
      pg8::EpiDown E{inp(C, I_BD), (const int*)(ws + WS_LIST), meta, (b16*)(ws + WS_Y), (b16*)(ws + WS_Y2), (pg8::moe_split_full(meta[MT_NT] * 4, C.G) >> 2) << 8}; pg8::gemm_phase<pg8::EpiDown, pg8::MoeSplitOrder, true, true, true, true>(ring, g, S, E); }
    xcd_barrier(bar);
    p_combine(C);
}

extern "C" void kernel_launch(void* const* d_in, const int* in_sizes, int n_in, void* d_out, int out_size, void* d_ws, size_t ws_size, hipStream_t stream) {
    static int grid = 0;
    if (grid == 0) {
        if (n_in != 18 || in_sizes[0] != TOK * DM || out_size != TOK * DM || ws_size < WS_END) { fprintf(stderr, "kernel_launch: unexpected shapes (n_in %d in0 %d out %d ws %zu)\n", n_in, n_in > 0 ? in_sizes[0] : -1, out_size, ws_size); grid = -1; return; }
        int dev = 0, cus = 0, per_cu = 0;
        if (hipGetDevice(&dev) != hipSuccess || hipDeviceGetAttribute(&cus, hipDeviceAttributeMultiprocessorCount, dev) != hipSuccess) { fprintf(stderr, "kernel_launch: device query failed\n"); grid = -1; return; }
        if (hipFuncSetAttribute((const void*)fwd, hipFuncAttributeMaxDynamicSharedMemorySize, LDS_BYTES) != hipSuccess) { fprintf(stderr, "kernel_launch: hipFuncSetAttribute failed\n"); grid = -1; return; }
        if (hipOccupancyMaxActiveBlocksPerMultiprocessor(&per_cu, (const void*)fwd, NTHR, LDS_BYTES) != hipSuccess || per_cu < 1) fprintf(stderr, "kernel_launch: note: occupancy query reports %d workgroups per CU\n", per_cu);
        (void)hipGetLastError();
        grid = cus;
    }
    if (grid < 0) return;
    if (hipMemsetAsync((char*)d_ws + WS_CTL, 0, CTL_ZERO_BYTES, stream) != hipSuccess) { fprintf(stderr, "kernel_launch: memset failed\n"); return; }
    Args a; memset(&a, 0, sizeof(a));
    for (int i = 0; i < 18; ++i) a.in[i] = (const float*)d_in[i];
    a.out = (float*)d_out; a.ws = (unsigned char*)d_ws;
    hipLaunchKernelGGL(fwd, dim3(grid), dim3(NTHR), LDS_BYTES, stream, a);
    const hipError_t le = hipPeekAtLastError();
    if (le != hipSuccess) fprintf(stderr, "kernel_launch: launch failed: %s\n", hipGetErrorName(le));
}
```
